# Optimizing an MI355X kernel written in HIP

```python
import jax, jax.numpy as jnp
from jax import lax
import numpy as np

D_MODEL = 1024
BATCH = 2
SEQ = 8192
DEPTH = 1

MIX_WIDTH = D_MODEL
RET_WIDTH = MIX_WIDTH // 2
CONV_WIDTH = MIX_WIDTH - RET_WIDTH
RET_HEADS = 4
RET_HEAD_DIM = RET_WIDTH // RET_HEADS
CHUNK = 128
CONV_KERNEL = 31
MEM_LEN = 256
XATTN_HEADS = 4
XATTN_HEAD_DIM = D_MODEL // XATTN_HEADS
D_FF = 4 * D_MODEL
ROPE_THETA = 10000.0
EPS = 1e-6
IN_COLS = 4 * RET_WIDTH + 2 * CONV_WIDTH

kernel_name = "hybrid_retention_conformer_xattn_block"


def rmsnorm(x, w):
    xf = x.astype(jnp.float32)
    y = xf * lax.rsqrt(jnp.mean(xf * xf, axis=-1, keepdims=True) + EPS)
    return (y * w.astype(jnp.float32)).astype(x.dtype)


def layernorm(x, w, b):
    xf = x.astype(jnp.float32)
    mu = jnp.mean(xf, axis=-1, keepdims=True)
    var = jnp.mean(jnp.square(xf - mu), axis=-1, keepdims=True)
    y = (xf - mu) * lax.rsqrt(var + EPS)
    return y * w.astype(jnp.float32) + b.astype(jnp.float32)


def rotary(x, positions):
    dh = x.shape[-1]
    half = dh // 2
    inv_freq = ROPE_THETA ** (-jnp.arange(half, dtype=jnp.float32) / half)
    ang = positions.astype(jnp.float32)[..., None] * inv_freq
    cos = jnp.cos(ang)[:, :, None, :]
    sin = jnp.sin(ang)[:, :, None, :]
    xf = x.astype(jnp.float32)
    x1, x2 = xf[..., :half], xf[..., half:]
    return jnp.concatenate([x1 * cos - x2 * sin, x2 * cos + x1 * sin], axis=-1)


def to_chunks(t):
    b, s, h, d = t.shape
    return t.reshape(b, s // CHUNK, CHUNK, h, d).transpose(0, 3, 1, 2, 4)


def from_chunks(t):
    b, h, nc, c, d = t.shape
    return t.transpose(0, 2, 3, 1, 4).reshape(b, nc * c, h, d)


def retention_chunkwise(q, k, v, log_gamma, include_diag):
    c = q.shape[3]
    idx = jnp.arange(c, dtype=jnp.float32)
    diff = idx[:, None] - idx[None, :]
    mask = (diff >= 0) if include_diag else (diff > 0)
    decay_in = jnp.where(mask[None], jnp.exp(log_gamma[:, None, None] * jnp.maximum(diff, 0.0)[None]), 0.0)
    scores = jnp.einsum('bhnqd,bhnkd->bhnqk', q, k) * decay_in[None, :, None]
    inner = jnp.einsum('bhnqk,bhnkd->bhnqd', scores, v)
    zeta = jnp.exp(log_gamma[:, None] * (c - 1 - idx)[None])
    chunk_kv = jnp.einsum('bhnkd,bhnke->bhnde', k * zeta[None, :, None, :, None], v)
    chunk_decay = jnp.exp(log_gamma * c)[None, :, None, None]

    def step(state, kv_n):
        return chunk_decay * state + kv_n, state

    init = jnp.zeros(chunk_kv.shape[:2] + chunk_kv.shape[3:], jnp.float32)
    _, r_prev = lax.scan(step, init, jnp.moveaxis(chunk_kv, 2, 0))
    r_prev = jnp.moveaxis(r_prev, 0, 2)
    xi = jnp.exp(log_gamma[:, None] * (idx + 1.0)[None])
    cross = jnp.einsum('bhnqd,bhnde->bhnqe', q * xi[None, :, None, :, None], r_prev)
    return inner + cross


def retention_group(proj_q, proj_k, proj_v, proj_g, positions, decay_f, decay_b, gn_w, gn_b):
    b, s, _ = proj_q.shape
    q = rotary(proj_q.reshape(b, s, RET_HEADS, RET_HEAD_DIM), positions)
    k = rotary(proj_k.reshape(b, s, RET_HEADS, RET_HEAD_DIM), positions) * (RET_HEAD_DIM ** -0.5)
    v = proj_v.reshape(b, s, RET_HEADS, RET_HEAD_DIM).astype(jnp.float32)
    lg_f = jax.nn.log_sigmoid(decay_f.astype(jnp.float32))
    lg_b = jax.nn.log_sigmoid(decay_b.astype(jnp.float32))
    y_f = from_chunks(retention_chunkwise(to_chunks(q), to_chunks(k), to_chunks(v), lg_f, True))
    y_b = from_chunks(retention_chunkwise(to_chunks(q[:, ::-1]), to_chunks(k[:, ::-1]),
                                          to_chunks(v[:, ::-1]), lg_b, False))[:, ::-1]
    y = y_f + y_b
    mu = jnp.mean(y, axis=-1, keepdims=True)
    var = jnp.mean(jnp.square(y - mu), axis=-1, keepdims=True)
    y = ((y - mu) * lax.rsqrt(var + EPS)).reshape(b, s, RET_WIDTH)
    y = y * gn_w.astype(jnp.float32) + gn_b.astype(jnp.float32)
    return (jax.nn.silu(proj_g.astype(jnp.float32)) * y).astype(proj_q.dtype)


def conformer_conv_group(proj_a, proj_b, conv_w, conv_b, ln_w, ln_b):
    u = proj_a * jax.nn.sigmoid(proj_b)
    pad = CONV_KERNEL // 2
    y = lax.conv_general_dilated(u, conv_w, window_strides=(1,), padding=((pad, pad),),
                                 dimension_numbers=('NWC', 'WIO', 'NWC'),
                                 feature_group_count=CONV_WIDTH) + conv_b
    y = layernorm(y, ln_w, ln_b)
    return jax.nn.silu(y).astype(proj_a.dtype)


def memory_cross_attention(h, m, w_q, w_kv, w_o):
    b, s, _ = h.shape
    q = (h @ w_q).reshape(b, s, XATTN_HEADS, XATTN_HEAD_DIM)
    kv = m @ w_kv
    k = kv[..., :D_MODEL].reshape(b, m.shape[1], XATTN_HEADS, XATTN_HEAD_DIM)
    v = kv[..., D_MODEL:].reshape(b, m.shape[1], XATTN_HEADS, XATTN_HEAD_DIM)
    scores = jnp.einsum('bshd,bmhd->bhsm', q.astype(jnp.float32), k.astype(jnp.float32)) * (XATTN_HEAD_DIM ** -0.5)
    p = jax.nn.softmax(scores, axis=-1)
    o = jnp.einsum('bhsm,bmhd->bshd', p, v.astype(jnp.float32)).reshape(b, s, D_MODEL)
    return o.astype(h.dtype) @ w_o


def setup_inputs(seed: int = 0) -> dict:
    key = jax.random.key(seed)
    ks = jax.random.split(key, 24)
    f32 = jnp.float32

    def nrm(k, shape, scale):
        return jax.random.normal(k, shape, f32) * scale

    def gain(k, shape):
        return 1.0 + 0.05 * jax.random.normal(k, shape, f32)

    g0 = 1.0 - 2.0 ** (-5.0 - np.arange(RET_HEADS, dtype=np.float32))
    base_logit = jnp.asarray(np.log(g0) - np.log1p(-g0), f32)
    return {
        "x": jax.random.normal(ks[0], (BATCH, SEQ, D_MODEL), f32),
        "mem": jax.random.normal(ks[1], (BATCH, MEM_LEN, D_MODEL), f32),
        "positions": jnp.broadcast_to(jnp.arange(SEQ, dtype=jnp.int32), (BATCH, SEQ)),
        "mix_norm_w": gain(ks[2], (DEPTH, D_MODEL)),
        "w_in": nrm(ks[3], (DEPTH, D_MODEL, IN_COLS), D_MODEL ** -0.5),
        "ret_decay_f": base_logit[None] + 0.1 * jax.random.normal(ks[4], (DEPTH, RET_HEADS), f32),
        "ret_decay_b": base_logit[None] + 0.1 * jax.random.normal(ks[5], (DEPTH, RET_HEADS), f32),
        "ret_gn_w": gain(ks[6], (DEPTH, RET_WIDTH)),
        "ret_gn_b": nrm(ks[7], (DEPTH, RET_WIDTH), 0.02),
        "conv_w": nrm(ks[8], (DEPTH, CONV_KERNEL, 1, CONV_WIDTH), CONV_KERNEL ** -0.5),
        "conv_b": nrm(ks[9], (DEPTH, CONV_WIDTH), 0.02),
        "conv_ln_w": gain(ks[10], (DEPTH, CONV_WIDTH)),
        "conv_ln_b": nrm(ks[11], (DEPTH, CONV_WIDTH), 0.02),
        "w_out": nrm(ks[12], (DEPTH, MIX_WIDTH, D_MODEL), MIX_WIDTH ** -0.5),
        "xattn_norm_w": gain(ks[13], (DEPTH, D_MODEL)),
        "mem_norm_w": gain(ks[14], (DEPTH, D_MODEL)),
        "w_xq": nrm(ks[15], (DEPTH, D_MODEL, D_MODEL), D_MODEL ** -0.5),
        "w_xkv": nrm(ks[16], (DEPTH, D_MODEL, 2 * D_MODEL), D_MODEL ** -0.5),
        "w_xo": nrm(ks[17], (DEPTH, D_MODEL, D_MODEL), D_MODEL ** -0.5),
        "mlp_norm_w": gain(ks[18], (DEPTH, D_MODEL)),
        "w_ff1": nrm(ks[19], (DEPTH, D_MODEL, D_FF), D_MODEL ** -0.5),
        "w_ff2": nrm(ks[20], (DEPTH, D_FF, D_MODEL), D_FF ** -0.5),
        "final_norm_w": gain(ks[21], (D_MODEL,)),
    }


def reference(x, mem, positions, mix_norm_w, w_in, ret_decay_f, ret_decay_b, ret_gn_w, ret_gn_b,
              conv_w, conv_b, conv_ln_w, conv_ln_b, w_out, xattn_norm_w, mem_norm_w,
              w_xq, w_xkv, w_xo, mlp_norm_w, w_ff1, w_ff2, final_norm_w):
    R = RET_WIDTH
    for l in range(DEPTH):
        h = rmsnorm(x, mix_norm_w[l])
        proj = h @ w_in[l]
        p_q, p_k, p_v, p_g = proj[..., :R], proj[..., R:2 * R], proj[..., 2 * R:3 * R], proj[..., 3 * R:4 * R]
        p_a = proj[..., 4 * R:4 * R + CONV_WIDTH]
        p_b = proj[..., 4 * R + CONV_WIDTH:]
        y_ret = retention_group(p_q, p_k, p_v, p_g, positions, ret_decay_f[l], ret_decay_b[l],
                                ret_gn_w[l], ret_gn_b[l])
        y_conv = conformer_conv_group(p_a, p_b, conv_w[l], conv_b[l], conv_ln_w[l], conv_ln_b[l])
        x = x + jnp.concatenate([y_ret, y_conv], axis=-1) @ w_out[l]
        x = x + memory_cross_attention(rmsnorm(x, xattn_norm_w[l]), rmsnorm(mem, mem_norm_w[l]),
                                       w_xq[l], w_xkv[l], w_xo[l])
        hm = rmsnorm(x, mlp_norm_w[l])
        x = x + jnp.square(jax.nn.relu(hm @ w_ff1[l])) @ w_ff2[l]
    return rmsnorm(x, final_norm_w)
```

```cpp
#include <hip/hip_runtime.h>
#include <hip/hip_cooperative_groups.h>
#include <cstdio>
#include <cstdint>
namespace cg = cooperative_groups;
namespace pg8 {
#define PG8_LAS __attribute__((address_space(3)))
typedef unsigned short bf16_t;
typedef short bf16x8 __attribute__((ext_vector_type(8)));
typedef float f32x4 __attribute__((ext_vector_type(4)));
typedef unsigned u32x4 __attribute__((ext_vector_type(4)));
constexpr int BM = 256, BK = 64, HALF = 128, HTB = HALF * BK * 2  , STAGE_BYTES = 8 * HTB, NXCD = 8, WGM = 8;

__host__ __device__ __forceinline__ int lds_byte(int r, int c) { const int st = (r >> 4) * 2 + (c >> 5), rr = r & 15, cc = c & 31, ob = rr * 64 + cc * 2; return st * 1024 + (ob ^ (((ob >> 9) & 1) << 5)); }
__host__ __device__ __forceinline__ void stage_rc(int b, int& R, int& C) { const int st = b / 1024, sb = b % 1024, swz = sb ^ (((sb >> 9) & 1) << 5); R = (st >> 1) * 16 + swz / 64; C = (st & 1) * 32 + (swz % 64) / 2; }
__host__ __device__ __forceinline__ int perm32(int rho) { const int n = rho >> 4, i = rho & 15; return 8 * (i >> 2) + 4 * n + (i & 3); }

struct Unit { int pm, pn; };
struct Gemm { const bf16_t* A; const bf16_t* Bt; int M, N, K; };

struct StaticOrder {
    int nM, nN, nwg, G, c;
    __host__ __device__ void init(int M, int N, int G_, int c_) { nM = M / BM; nN = N / BM; nwg = nM * nN; G = G_; c = c_; }
    __host__ __device__ bool next(int i, Unit& u) const {
        const long L = (long)i * G + c; if (L >= nwg) return false;
        int wgid = (int)L; { const int q = nwg / NXCD, r = nwg % NXCD, xcd = wgid % NXCD, off = wgid / NXCD; wgid = (xcd < r ? xcd * (q + 1) : r * (q + 1) + (xcd - r) * q) + off; }
        const int nig = WGM * nN, gid = wgid / nig, fm = gid * WGM, gsz = (nM - fm) < WGM ? (nM - fm) : WGM;
        u.pm = fm + ((wgid % nig) % gsz); u.pn = (wgid % nig) / gsz; return true;
    }
    __device__ __forceinline__ void a_ready(const Unit&) const {}
    __device__ __forceinline__ void done(const Unit&) const {}
};

typedef float f32x2_t __attribute__((ext_vector_type(2)));
typedef __bf16 bf16x2_t __attribute__((ext_vector_type(2)));
__device__ __forceinline__ unsigned cvt_pk_bf16(float lo, float hi) { f32x2_t v = {lo, hi}; bf16x2_t b = __builtin_convertvector(v, bf16x2_t); return __builtin_bit_cast(unsigned, b); }
typedef float f32x2 __attribute__((ext_vector_type(2)));
typedef unsigned u32x2 __attribute__((ext_vector_type(2)));
template <int ACT> struct EpiBf16 {
    static constexpr bool PERM = true, AFTER_DRAIN = false;
    bf16_t* O; int ldc; const float* rowsq;
    __device__ __forceinline__ void operator()(const f32x4 (&acc)[2][2][4][2], const Unit& u, int wr, int wc, int fr, int fq) const {
        const int row0 = u.pm * BM + wr * 64 + fr; const int col0 = u.pn * BM + wc * 32 + 8 * fq;
        const __amdgpu_buffer_rsrc_t rsrc = __builtin_amdgcn_make_buffer_rsrc((void*)O, (short)0, 16384 * ldc * 2, 0x00020000);
#pragma unroll
        for (int ai = 0; ai < 2; ++ai)
#pragma unroll
            for (int m = 0; m < 4; ++m) { const int row = row0 + ai * HALF + m * 16;
                const float rs = rowsq ? rsqrtf(rowsq[row] * (1.0f / 1024.0f) + 1e-6f) : 1.0f;
#pragma unroll
                for (int bj = 0; bj < 2; ++bj) { f32x4 v0 = acc[ai][bj][m][0] * rs, v1 = acc[ai][bj][m][1] * rs;
                    if (ACT == 1) { const f32x4 z = (f32x4){0.f, 0.f, 0.f, 0.f}; const f32x4 a0 = __builtin_elementwise_max(v0, z), a1 = __builtin_elementwise_max(v1, z); v0 = a0 * a0; v1 = a1 * a1; }
                    u32x4 w; w.x = cvt_pk_bf16(v0[0], v0[1]); w.y = cvt_pk_bf16(v0[2], v0[3]); w.z = cvt_pk_bf16(v1[0], v1[1]); w.w = cvt_pk_bf16(v1[2], v1[3]);
                    __builtin_amdgcn_raw_buffer_store_b128(w, rsrc, (unsigned)(((size_t)row * ldc + col0 + bj * HALF) * 2), 0,   16); } }
    }
};
template <int MODE> struct EpiResidual {
    static constexpr bool PERM = true, AFTER_DRAIN = false;
    const float* basef; bf16_t* xb; float* outf; int ldc; float* rowsq;
    __device__ __forceinline__ void operator()(const f32x4 (&acc)[2][2][4][2], const Unit& u, int wr, int wc, int fr, int fq) const {
        const int col0 = u.pn * BM + wc * 32 + 8 * fq;
        const __amdgpu_buffer_rsrc_t rsrc = __builtin_amdgcn_make_buffer_rsrc((void*)xb, (short)0, 16384 * 1024 * 2, 0x00020000);
#pragma unroll
        for (int ai = 0; ai < 2; ++ai)
#pragma unroll
            for (int m = 0; m < 4; ++m) { const int row = u.pm * BM + ai * HALF + wr * 64 + m * 16 + fr; const size_t off = (size_t)row * ldc + col0; float ss = 0.f;
#pragma unroll
                for (int bj = 0; bj < 2; ++bj) { const size_t o2 = off + bj * HALF; f32x4 b0, b1;
                    if (MODE == 0) { b0 = *(const f32x4*)(basef + o2); b1 = *(const f32x4*)(basef + o2 + 4); }
                    else { const u32x4 w = *(const u32x4*)(xb + o2);
                        b0 = (f32x4){__uint_as_float(w.x << 16), __uint_as_float(w.x & 0xffff0000u), __uint_as_float(w.y << 16), __uint_as_float(w.y & 0xffff0000u)};
                        b1 = (f32x4){__uint_as_float(w.z << 16), __uint_as_float(w.z & 0xffff0000u), __uint_as_float(w.w << 16), __uint_as_float(w.w & 0xffff0000u)}; }
                    const f32x4 v0 = b0 + acc[ai][bj][m][0], v1 = b1 + acc[ai][bj][m][1];
                    if (MODE == 2) { *(f32x4*)(outf + o2) = v0; *(f32x4*)(outf + o2 + 4) = v1; }
                    else { ss += (v0[0] * v0[0] + v0[1] * v0[1]) + (v0[2] * v0[2] + v0[3] * v0[3]) + (v1[0] * v1[0] + v1[1] * v1[1]) + (v1[2] * v1[2] + v1[3] * v1[3]);
                        u32x4 w; w.x = cvt_pk_bf16(v0[0], v0[1]); w.y = cvt_pk_bf16(v0[2], v0[3]); w.z = cvt_pk_bf16(v1[0], v1[1]); w.w = cvt_pk_bf16(v1[2], v1[3]);
                        __builtin_amdgcn_raw_buffer_store_b128(w, rsrc, (unsigned)(o2 * 2), 0, 16); } }
                if (MODE != 2) { ss += __shfl_xor(ss, 16); ss += __shfl_xor(ss, 32); if (fq == 0) atomicAdd(rowsq + row, ss); } }
    }
};
struct EpiFinalNorm {
    static constexpr bool PERM = false, AFTER_DRAIN = true;
    const bf16_t* xb; float* outf; int ldc; const float* nw; float* rowsq; unsigned* cnt;
    __device__ __forceinline__ void fused(f32x4 (&acc)[2][2][4][2], const Unit& u, int wr, int wc, int fr, int fq, PG8_LAS unsigned char* lds, int wid, int lane) const {
        const int col0 = u.pn * BM + wc * 32 + 4 * fq;
#pragma unroll
        for (int ai = 0; ai < 2; ++ai)
#pragma unroll
            for (int m = 0; m < 4; ++m) { const int row = u.pm * BM + ai * HALF + wr * 64 + m * 16 + fr; const size_t off = (size_t)row * ldc + col0; float ss = 0.f;
#pragma unroll
                for (int bj = 0; bj < 2; ++bj)
#pragma unroll
                    for (int n = 0; n < 2; ++n) { const u32x2 w = *(const u32x2*)(xb + off + bj * HALF + n * 16);
                        const f32x4 bs = (f32x4){__uint_as_float(w.x << 16), __uint_as_float(w.x & 0xffff0000u), __uint_as_float(w.y << 16), __uint_as_float(w.y & 0xffff0000u)};
                        const f32x4 v = bs + acc[ai][bj][m][n]; acc[ai][bj][m][n] = v; ss += (v[0] * v[0] + v[1] * v[1]) + (v[2] * v[2] + v[3] * v[3]); }
                ss += __shfl_xor(ss, 16); ss += __shfl_xor(ss, 32); if (fq == 0) atomicAdd(rowsq + row, ss); }
        asm volatile("s_waitcnt vmcnt(0)" ::: "memory");
        __syncthreads();
        if (threadIdx.x == 0) {
            unsigned* c = cnt + 64 * u.pm;
            __hip_atomic_fetch_add(c, 1u, __ATOMIC_RELEASE, __HIP_MEMORY_SCOPE_AGENT);
            unsigned spins = 0;
            while (__hip_atomic_load(c, __ATOMIC_ACQUIRE, __HIP_MEMORY_SCOPE_AGENT) < 4u) { __builtin_amdgcn_s_sleep(2); if (++spins > (1u << 22)) break; }
        }
        __syncthreads();
        const __amdgpu_buffer_rsrc_t orsrc = __builtin_amdgcn_make_buffer_rsrc((void*)outf, (short)0, 16384 * 1024 * 4, 0x00020000);
        f32x4 nwv[2][2];
#pragma unroll
        for (int bj = 0; bj < 2; ++bj)
#pragma unroll
            for (int n = 0; n < 2; ++n) nwv[bj][n] = *(const f32x4*)(nw + col0 + bj * HALF + n * 16);
#pragma unroll
        for (int ai = 0; ai < 2; ++ai)
#pragma unroll
            for (int m = 0; m < 4; ++m) { const int row = u.pm * BM + ai * HALF + wr * 64 + m * 16 + fr; const size_t off = (size_t)row * ldc + col0;
                const float rs = rsqrtf(__hip_atomic_load(rowsq + row, __ATOMIC_RELAXED, __HIP_MEMORY_SCOPE_AGENT) * (1.0f / 1024.0f) + 1e-6f);
#pragma unroll
                for (int bj = 0; bj < 2; ++bj)
#pragma unroll
                    for (int n = 0; n < 2; ++n) { const f32x4 y = acc[ai][bj][m][n] * rs * nwv[bj][n]; __builtin_amdgcn_raw_buffer_store_b128(__builtin_bit_cast(u32x4, y), orsrc, (unsigned)((off + bj * HALF + n * 16) * 4), 0, 16); } }
    }
};
struct EpiKV {
    static constexpr bool PERM = false, AFTER_DRAIN = true;
    bf16_t* Kx; bf16_t* VTx;
    __device__ __forceinline__ void fused(f32x4 (&acc)[2][2][4][2], const Unit& u, int wr, int wc, int fr, int fq, PG8_LAS unsigned char* lds, int wid, int lane) const {
        const bool isv = u.pn >= 4; const int h = isv ? u.pn - 4 : u.pn;
        bf16_t* base = (isv ? VTx : Kx) + (size_t)(u.pm * 4 + h) * 65536;
        const int col0 = wc * 32 + 4 * fq;
        if (!isv) {
#pragma unroll
            for (int ai = 0; ai < 2; ++ai)
#pragma unroll
                for (int m = 0; m < 4; ++m) { const int key = ai * HALF + wr * 64 + m * 16 + fr;
#pragma unroll
                    for (int bj = 0; bj < 2; ++bj)
#pragma unroll
                        for (int n = 0; n < 2; ++n) { const f32x4 v = acc[ai][bj][m][n]; const int c = col0 + bj * HALF + n * 16;
                            u32x2 w; w.x = cvt_pk_bf16(v[0], v[1]); w.y = cvt_pk_bf16(v[2], v[3]); *(u32x2*)(base + (size_t)key * 256 + c) = w; } }
        } else {
            PG8_LAS bf16_t* T = (PG8_LAS bf16_t*)lds;
#pragma unroll
            for (int ai = 0; ai < 2; ++ai)
#pragma unroll
                for (int m = 0; m < 4; ++m) { const int key = ai * HALF + wr * 64 + m * 16 + fr;
#pragma unroll
                    for (int bj = 0; bj < 2; ++bj)
#pragma unroll
                        for (int n = 0; n < 2; ++n) { const f32x4 v = acc[ai][bj][m][n]; const int c = col0 + bj * HALF + n * 16;
                            const unsigned w0 = cvt_pk_bf16(v[0], v[1]), w1 = cvt_pk_bf16(v[2], v[3]);
                            T[(c + 0) * 264 + key] = (bf16_t)(w0 & 0xffffu); T[(c + 1) * 264 + key] = (bf16_t)(w0 >> 16); T[(c + 2) * 264 + key] = (bf16_t)(w1 & 0xffffu); T[(c + 3) * 264 + key] = (bf16_t)(w1 >> 16); } }
            __syncthreads();
            const int tid = wid * 64 + lane;
#pragma unroll 4
            for (int i = 0; i < 16; ++i) { const int id = tid + 512 * i, r = id >> 5, ch = id & 31; *(u32x4*)(base + (size_t)r * 256 + ch * 8) = *(const PG8_LAS u32x4*)(T + r * 264 + ch * 8); }
        }
    }
};

template <class Epi, class Sched, bool ALIGN_EPI = false, bool SP2 = false>
__device__ __forceinline__ void gemm_phase(PG8_LAS unsigned char* lds, const Gemm g, const Sched& S, const Epi& E) {
    const int tid = threadIdx.x, wid = __builtin_amdgcn_readfirstlane(tid >> 6), lane = tid & 63, wr = wid >> 2, wc = wid & 3, fr = lane & 15, fq = lane >> 4;
    const int K = g.K, nt = K / BK;
    unsigned voffA[2], voffB[2];
#pragma unroll
    for (int i = 0; i < 2; ++i) { int R, C; stage_rc(tid * 16 + i * 8192, R, C); const int Rb = Epi::PERM ? ((R & ~31) + perm32(R & 31)) : R;
        voffA[i] = (unsigned)(R * K + C) * 2u; voffB[i] = (unsigned)(Rb * K + C) * 2u; }
    const size_t kstep = (size_t)(BK * 2);
    const size_t hstep = (size_t)HALF * K * 2;
    const size_t tstep = 2 * hstep;
    const unsigned ldsw = (unsigned)wid * 1024u;
    const int aoff = lds_byte(wr * 64 + fr, fq * 8), boff = lds_byte(wc * 32 + fr, fq * 8);
#define PG8_SA(b, h) (((b) * 2 + (h)) * HTB)
#define PG8_SB(b, h) ((4 + (b) * 2 + (h)) * HTB)
#define PG8_STAGE(bufoff, gbase, voff) do { _Pragma("unroll") for (int _i = 0; _i < 2; ++_i) \
        __builtin_amdgcn_global_load_lds((const unsigned*)((const char*)(gbase) + (voff)[_i]), (PG8_LAS unsigned*)(lds + (bufoff) + ldsw + _i * 8192), 16, 0, 0); } while (0)
#define PG8_LDA(dst, b, h) do { _Pragma("unroll") for (int m = 0; m < 4; ++m) _Pragma("unroll") for (int k = 0; k < 2; ++k) dst[m][k] = *(const PG8_LAS bf16x8*)(lds + PG8_SA(b, h) + aoff + m * 2048 + k * 1024); } while (0)
#define PG8_LDB(dst, b, h) do { _Pragma("unroll") for (int n = 0; n < 2; ++n) _Pragma("unroll") for (int k = 0; k < 2; ++k) dst[n][k] = *(const PG8_LAS bf16x8*)(lds + PG8_SB(b, h) + boff + n * 2048 + k * 1024); } while (0)
#define PG8_MMA(ai, bj, At, Bt) do { __builtin_amdgcn_s_setprio(1); _Pragma("unroll") for (int m = 0; m < 4; ++m) _Pragma("unroll") for (int n = 0; n < 2; ++n) _Pragma("unroll") for (int k = 0; k < 2; ++k) \
        acc[ai][bj][m][n] = __builtin_amdgcn_mfma_f32_16x16x32_bf16(Bt[n][k], At[m][k], acc[ai][bj][m][n], 0, 0, 0); __builtin_amdgcn_s_setprio(0); } while (0)
#define PG8_WAIT_V(n) asm volatile("s_waitcnt vmcnt(" #n ")" ::: "memory")
#define PG8_WAIT_L(n) asm volatile("s_waitcnt lgkmcnt(" #n ")" ::: "memory")
#define PG8_BAR __builtin_amdgcn_s_barrier()
#define PG8_SCHED __builtin_amdgcn_sched_barrier(0)
    Unit cur, nxt; int ui = 0;
    if (!S.next(0, cur)) return;
    f32x4 acc[2][2][4][2];
#pragma unroll
    for (int a = 0; a < 2; ++a)
#pragma unroll
        for (int b = 0; b < 2; ++b)
#pragma unroll
            for (int m = 0; m < 4; ++m)
#pragma unroll
                for (int n = 0; n < 2; ++n) acc[a][b][m][n] = (f32x4){0.f, 0.f, 0.f, 0.f};
    bf16x8 At[4][2], B0[2][2], B1[2][2];
    const char* cA = (const char*)g.A + (size_t)cur.pm * tstep; const char* cB = (const char*)g.Bt + (size_t)cur.pn * tstep;
    S.a_ready(cur);
    if constexpr (SP2) {
        PG8_STAGE(PG8_SB(0, 0), cB, voffB); PG8_STAGE(PG8_SB(0, 1), cB + hstep, voffB); PG8_STAGE(PG8_SA(0, 0), cA, voffA); PG8_STAGE(PG8_SA(0, 1), cA + hstep, voffA);
        if (wr == 1) PG8_BAR;
        PG8_WAIT_V(2); PG8_BAR;
        PG8_STAGE(PG8_SB(1, 0), cB + kstep, voffB); PG8_STAGE(PG8_SA(1, 0), cA + kstep, voffA); PG8_STAGE(PG8_SB(1, 1), cB + hstep + kstep, voffB);
        PG8_WAIT_V(6); PG8_BAR;
    } else {
        PG8_STAGE(PG8_SB(0, 0), cB, voffB); PG8_STAGE(PG8_SA(0, 0), cA, voffA); PG8_STAGE(PG8_SB(0, 1), cB + hstep, voffB); PG8_STAGE(PG8_SA(0, 1), cA + hstep, voffA);
        if (wr == 1) PG8_BAR;
        PG8_WAIT_V(4); PG8_BAR;
        PG8_STAGE(PG8_SB(1, 0), cB + kstep, voffB); PG8_STAGE(PG8_SA(1, 0), cA + kstep, voffA); PG8_STAGE(PG8_SB(1, 1), cB + hstep + kstep, voffB);
        PG8_WAIT_V(6); PG8_BAR;
    }
    for (;;) {
        const bool has_next = S.next(ui + 1, nxt);
        const char* nA = has_next ? (const char*)g.A + (size_t)nxt.pm * tstep : cA; const char* nB = has_next ? (const char*)g.Bt + (size_t)nxt.pn * tstep : cB;
        for (int t = 0; t < nt; t += 2) {
            const bool last = (t == nt - 2);
            const char* a1 = cA + (size_t)(t + 1) * kstep;
            const char* a2 = last ? nA : cA + (size_t)(t + 2) * kstep; const char* b2 = last ? nB : cB + (size_t)(t + 2) * kstep;
            const char* a3 = a2 + kstep; const char* b3 = b2 + kstep;
            if (last && has_next) S.a_ready(nxt);
            if constexpr (SP2) {
            PG8_LDB(B0, 0, 0); PG8_LDB(B1, 0, 1); PG8_SCHED; PG8_LDA(At, 0, 0); PG8_STAGE(PG8_SA(1, 1), a1 + hstep, voffA);
            PG8_WAIT_V(8); PG8_WAIT_L(0); PG8_BAR; PG8_MMA(0, 0, At, B0); PG8_MMA(0, 1, At, B1); PG8_BAR; PG8_SCHED;
            PG8_LDA(At, 0, 1); PG8_STAGE(PG8_SB(0, 0), b2, voffB); PG8_STAGE(PG8_SB(0, 1), b2 + hstep, voffB); PG8_STAGE(PG8_SA(0, 0), a2, voffA);
            PG8_WAIT_V(8); PG8_WAIT_L(0); PG8_BAR; PG8_MMA(1, 0, At, B0); PG8_MMA(1, 1, At, B1); PG8_BAR; PG8_SCHED;
            PG8_LDB(B0, 1, 0); PG8_LDB(B1, 1, 1); PG8_SCHED; PG8_LDA(At, 1, 0); PG8_STAGE(PG8_SA(0, 1), a2 + hstep, voffA);
            PG8_WAIT_V(8); PG8_WAIT_L(0); PG8_BAR; PG8_MMA(0, 0, At, B0); PG8_MMA(0, 1, At, B1); PG8_BAR; PG8_SCHED;
            PG8_LDA(At, 1, 1); PG8_STAGE(PG8_SB(1, 0), b3, voffB); PG8_STAGE(PG8_SB(1, 1), b3 + hstep, voffB); PG8_STAGE(PG8_SA(1, 0), a3, voffA);
            PG8_WAIT_V(8); PG8_WAIT_L(0); PG8_BAR; PG8_MMA(1, 0, At, B0); PG8_MMA(1, 1, At, B1); PG8_BAR; PG8_SCHED;
            } else {
            PG8_LDB(B0, 0, 0); PG8_SCHED; PG8_LDA(At, 0, 0); PG8_STAGE(PG8_SA(1, 1), a1 + hstep, voffA);
            PG8_WAIT_L(8); PG8_BAR; PG8_WAIT_L(0); PG8_MMA(0, 0, At, B0); PG8_BAR; PG8_SCHED;
            PG8_LDB(B1, 0, 1); PG8_STAGE(PG8_SB(0, 0), b2, voffB);
            PG8_BAR; PG8_WAIT_L(0); PG8_MMA(0, 1, At, B1); PG8_BAR;
            PG8_LDA(At, 0, 1); PG8_STAGE(PG8_SA(0, 0), a2, voffA);
            PG8_BAR; PG8_WAIT_L(0); PG8_MMA(1, 0, At, B0); PG8_BAR; PG8_SCHED;
            PG8_STAGE(PG8_SB(0, 1), b2 + hstep, voffB);
            PG8_WAIT_V(6); PG8_BAR; PG8_MMA(1, 1, At, B1); PG8_BAR;
            PG8_LDB(B0, 1, 0); PG8_SCHED; PG8_LDA(At, 1, 0); PG8_STAGE(PG8_SA(0, 1), a2 + hstep, voffA);
            PG8_WAIT_L(8); PG8_BAR; PG8_WAIT_L(0); PG8_MMA(0, 0, At, B0); PG8_BAR; PG8_SCHED;
            PG8_LDB(B1, 1, 1); PG8_STAGE(PG8_SB(1, 0), b3, voffB);
            PG8_BAR; PG8_WAIT_L(0); PG8_MMA(0, 1, At, B1); PG8_BAR;
            PG8_LDA(At, 1, 1); PG8_STAGE(PG8_SA(1, 0), a3, voffA);
            PG8_BAR; PG8_WAIT_L(0); PG8_MMA(1, 0, At, B0); PG8_BAR; PG8_SCHED;
            PG8_STAGE(PG8_SB(1, 1), b3 + hstep, voffB);
            PG8_WAIT_V(6); PG8_BAR; PG8_MMA(1, 1, At, B1); PG8_BAR;
            }
        }
        if constexpr (ALIGN_EPI) { if (wr == 0) PG8_BAR; }
        if constexpr (!Epi::AFTER_DRAIN) { E(acc, cur, wr, wc, fr, fq); S.done(cur); }
        if (!has_next) break;
#pragma unroll
        for (int a = 0; a < 2; ++a)
#pragma unroll
            for (int b = 0; b < 2; ++b)
#pragma unroll
                for (int m = 0; m < 4; ++m)
#pragma unroll
                    for (int n = 0; n < 2; ++n) acc[a][b][m][n] = (f32x4){0.f, 0.f, 0.f, 0.f};
        cur = nxt; cA = nA; cB = nB; ++ui;
        if constexpr (ALIGN_EPI) { if (wr == 1) PG8_BAR; }
    }
    PG8_WAIT_V(0);
    if constexpr (!ALIGN_EPI) { if (wr == 0) PG8_BAR; }
    PG8_BAR;
    if constexpr (Epi::AFTER_DRAIN) { E.fused(acc, cur, wr, wc, fr, fq, lds, wid, lane); S.done(cur); }
#undef PG8_SA
#undef PG8_SB
#undef PG8_STAGE
#undef PG8_LDA
#undef PG8_LDB
#undef PG8_MMA
#undef PG8_WAIT_V
#undef PG8_WAIT_L
#undef PG8_BAR
#undef PG8_SCHED
}
}

#ifndef MK_N_LAUNCHES
#define MK_N_LAUNCHES 1
#endif
constexpr int BATCH = 2, SEQ = 8192, D = 1024, M = BATCH * SEQ, INC = 3072, FF = 4096;
constexpr int NPH = 14;
constexpr float EPS = 1e-6f;
constexpr float LOG2E = 1.4426950408889634f;
constexpr size_t MiB = 1u << 20;
constexpr size_t WS_CTL = 0, CTL_ZERO_BYTES = 393216;
constexpr int MISC_OFF = 147392;
constexpr size_t WS_WIN = 1 * MiB, WS_WOUT = 7 * MiB, WS_WXQ = 9 * MiB, WS_WXKV = 11 * MiB, WS_WXO = 15 * MiB, WS_WFF1 = 17 * MiB, WS_WFF2 = 25 * MiB;
constexpr size_t WS_MEMN = 33 * MiB, WS_KX = 34 * MiB, WS_VTX = 35 * MiB;
constexpr size_t WS_H = 40 * MiB;
constexpr size_t WS_MIX = 72 * MiB;
constexpr size_t WS_QO = 104 * MiB;
constexpr size_t WS_PROJ = 136 * MiB;
constexpr size_t WS_F = 104 * MiB;
constexpr size_t WS_END = 232 * MiB;
constexpr int LDS_BYTES = 147456;

#define LAS __attribute__((address_space(3)))
typedef unsigned short bf16;
typedef float f32x4 __attribute__((ext_vector_type(4)));
typedef short bf16x8 __attribute__((ext_vector_type(8)));
typedef unsigned u32x4 __attribute__((ext_vector_type(4)));
typedef unsigned u32x2 __attribute__((ext_vector_type(2)));
#define LDS_WAIT() asm volatile("s_waitcnt lgkmcnt(0)" ::: "memory")

__device__ __forceinline__ unsigned pk2(float lo, float hi) { return pg8::cvt_pk_bf16(lo, hi); }
__device__ __forceinline__ float bflo(unsigned w) { return __uint_as_float(w << 16); }
__device__ __forceinline__ float bfhi(unsigned w) { return __uint_as_float(w & 0xffff0000u); }
__device__ __forceinline__ float bfe(const u32x4& w, int e) { const unsigned x = w[e >> 1]; return (e & 1) ? bfhi(x) : bflo(x); }
struct WsRef { __amdgpu_buffer_rsrc_t r; const unsigned char* base; };
__device__ __forceinline__ u32x4 ws_load16(const WsRef& w, unsigned byte_off) { return __builtin_bit_cast(u32x4, __builtin_amdgcn_raw_buffer_load_b128(w.r, byte_off, 0, 0)); }
__device__ __forceinline__ void wt_store8(const WsRef& w, const void* p, u32x2 v) { __builtin_amdgcn_raw_buffer_store_b64(v, w.r, (unsigned)((const unsigned char*)p - w.base), 0, 16); }
__device__ __forceinline__ void wt_store16(const WsRef& w, const void* p, u32x4 v) { __builtin_amdgcn_raw_buffer_store_b128(v, w.r, (unsigned)((const unsigned char*)p - w.base), 0, 16); }
__device__ __forceinline__ float wave_sum(float v) {
#pragma unroll
    for (int o = 1; o < 64; o <<= 1) v += __shfl_xor(v, o);
    return v;
}
__device__ __forceinline__ void fast_sincos(float ang, float& s, float& c) {
    const float k = rintf(ang * 0.15915494309189535f);
    float r = fmaf(-k, 6.28125f, ang);
    r = fmaf(-k, 0.0019353071795864769f, r);
    s = __sinf(r); c = __cosf(r);
}
__device__ __forceinline__ float fexp2(float x) { return __builtin_amdgcn_exp2f(x); }
__device__ __forceinline__ float log_sigmoid(float x) { return -log1pf(expf(-x)); }

__device__ __forceinline__ void p0_transpose_item(const float* W, int K, int N, bf16* WT, LAS float* scr, int item, int lane, const float* kscale = nullptr) {
    const int nblk = N / 32, kb = item / nblk, nb = item % nblk, k0 = 64 * kb, n0 = 32 * nb;
#pragma unroll 8
    for (int i = 0; i < 32; ++i) { const int kk = 2 * i + (lane >> 5); scr[kk * 33 + (lane & 31)] = W[(size_t)(k0 + kk) * N + n0 + (lane & 31)] * (kscale ? kscale[k0 + kk] : 1.0f); }
    LDS_WAIT(); asm volatile("" ::: "memory");
    const int c = lane & 7;
#pragma unroll
    for (int j = 0; j < 4; ++j) { const int n = (lane >> 3) + 8 * j; const LAS float* s = scr + (8 * c) * 33 + n;
        u32x4 o; o.x = pk2(s[0 * 33], s[1 * 33]); o.y = pk2(s[2 * 33], s[3 * 33]); o.z = pk2(s[4 * 33], s[5 * 33]); o.w = pk2(s[6 * 33], s[7 * 33]);
        *(u32x4*)(WT + (size_t)(n0 + n) * K + k0 + 8 * c) = o; }
    LDS_WAIT(); asm volatile("" ::: "memory");
}
__device__ __forceinline__ void p0_transpose_item64(const WsRef& wsr, const float* W, int K, int N, bf16* WT, LAS float* scr, int item, int lane, const float* kscale = nullptr) {
    const int nblk = N / 64, kb = item / nblk, nb = item % nblk, k0 = 64 * kb, n0 = 64 * nb;
    const int kq = lane >> 4, nq = lane & 15;
    f32x4 v[16];
#pragma unroll
    for (int i = 0; i < 16; ++i) v[i] = *(const f32x4*)(W + (size_t)(k0 + 4 * i + kq) * N + n0 + nq * 4);
#pragma unroll
    for (int i = 0; i < 16; ++i) { const int kk = 4 * i + kq; const float sc = kscale ? kscale[k0 + kk] : 1.0f; LAS float* d = scr + kk * 65 + nq * 4;
        d[0] = v[i][0] * sc; d[1] = v[i][1] * sc; d[2] = v[i][2] * sc; d[3] = v[i][3] * sc; }
    LDS_WAIT(); asm volatile("" ::: "memory");
    const int c = lane & 7;
#pragma unroll
    for (int j = 0; j < 8; ++j) { const int n = (lane >> 3) + 8 * j; const LAS float* s = scr + (8 * c) * 65 + n;
        u32x4 o; o.x = pk2(s[0 * 65], s[1 * 65]); o.y = pk2(s[2 * 65], s[3 * 65]); o.z = pk2(s[4 * 65], s[5 * 65]); o.w = pk2(s[6 * 65], s[7 * 65]);
        wt_store16(wsr, WT + (size_t)(n0 + n) * K + k0 + 8 * c, o); }
    LDS_WAIT(); asm volatile("" ::: "memory");
}
__device__ __forceinline__ void rms_row_to_bf16(const float* xrow, const float* w, bf16* orow, int lane) {
    const f32x4* xr = (const f32x4*)xrow + lane; const f32x4* wr = (const f32x4*)w + lane;
    f32x4 v[4]; float s = 0.f;
#pragma unroll
    for (int j = 0; j < 4; ++j) { v[j] = xr[64 * j]; s += (v[j].x * v[j].x + v[j].y * v[j].y) + (v[j].z * v[j].z + v[j].w * v[j].w); }
    const float rstd = rsqrtf(wave_sum(s) * (1.f / D) + EPS);
    u32x2* o8 = (u32x2*)orow + lane;
#pragma unroll
    for (int j = 0; j < 4; ++j) { const f32x4 ww = wr[64 * j]; u32x2 o; o.x = pk2(v[j].x * rstd * ww.x, v[j].y * rstd * ww.y); o.y = pk2(v[j].z * rstd * ww.z, v[j].w * rstd * ww.w); o8[64 * j] = o; }
}
__device__ __forceinline__ void rms_row_to_f32(const float* xrow, const float* w, float* orow, int lane) {
    const f32x4* xr = (const f32x4*)xrow + lane; const f32x4* wr = (const f32x4*)w + lane;
    f32x4 v[4]; float s = 0.f;
#pragma unroll
    for (int j = 0; j < 4; ++j) { v[j] = xr[64 * j]; s += (v[j].x * v[j].x + v[j].y * v[j].y) + (v[j].z * v[j].z + v[j].w * v[j].w); }
    const float rstd = rsqrtf(wave_sum(s) * (1.f / D) + EPS);
    f32x4* o = (f32x4*)orow + lane;
#pragma unroll
    for (int j = 0; j < 4; ++j) { const f32x4 ww = wr[64 * j]; o[64 * j] = v[j] * rstd * ww; }
}

constexpr int LDT = 136;
constexpr int TILE_B = 128 * LDT * 2;
#define MFMA16(a, b, c) __builtin_amdgcn_mfma_f32_16x16x32_bf16((a), (b), (c), 0, 0, 0)

struct UnitRaw { u32x4 a1[2], a2[2], k1[2], k2[2], v[4]; float p[2]; };
template <bool WITHQ> __device__ __forceinline__ void raw_load(UnitRaw& r, int u, const bf16* PROJ, const int* pos, int tid) {
    const int bh = u >> 6, c = u & 63, b = bh >> 2, h = bh & 3; const size_t row0 = (size_t)b * SEQ + (size_t)c * 128;
#pragma unroll
    for (int i = 0; i < 2; ++i) { const int it = tid + 512 * i, dc = it & 7, j = it >> 3; const bf16* qr = PROJ + (row0 + j) * INC + h * 128 + dc * 8; const bf16* kr = qr + 512;
        if (WITHQ) { r.a1[i] = *(const u32x4*)qr; r.a2[i] = *(const u32x4*)(qr + 64); }
        r.k1[i] = *(const u32x4*)kr; r.k2[i] = *(const u32x4*)(kr + 64); r.p[i] = (float)pos[row0 + j]; }
#pragma unroll
    for (int i = 0; i < 4; ++i) { const int it = tid + 512 * i, ec = it & 15, j = it >> 4; r.v[i] = *(const u32x4*)(PROJ + (row0 + j) * INC + 1024 + h * 128 + ec * 8); }
}
__device__ __forceinline__ void stage_vt_regs(LAS bf16* VT, const UnitRaw& r, int tid) {
#pragma unroll
    for (int i = 0; i < 4; ++i) { const int it = tid + 512 * i, ec = it & 15, j = it >> 4; const u32x4 w = r.v[i];
        const int jsw = (((j >> 3) ^ (ec & 7)) << 3) | (j & 7);
#pragma unroll
        for (int e = 0; e < 4; ++e) { VT[(ec * 8 + 2 * e) * LDT + jsw] = (bf16)(w[e] & 0xffffu); VT[(ec * 8 + 2 * e + 1) * LDT + jsw] = (bf16)(w[e] >> 16); } }
}
__device__ __forceinline__ void stage_vt(LAS bf16* VT, const bf16* PROJ, size_t row0, int h, int tid) {
    for (int it = tid; it < 2048; it += 512) { const int ec = it & 15, j = it >> 4;
        const u32x4 w = *(const u32x4*)(PROJ + (row0 + j) * INC + 1024 + h * 128 + ec * 8);
        const int jsw = (((j >> 3) ^ (ec & 7)) << 3) | (j & 7);
#pragma unroll
        for (int e = 0; e < 4; ++e) { VT[(ec * 8 + 2 * e) * LDT + jsw] = (bf16)(w[e] & 0xffffu); VT[(ec * 8 + 2 * e + 1) * LDT + jsw] = (bf16)(w[e] >> 16); } }
}

__device__ __forceinline__ void kv_unit(LAS unsigned char* lds, int u, const bf16* PROJ, const int* pos, const float* dec_f, const float* dec_b, bf16* KVc, int tid, UnitRaw& raw, int next_u) {
    const int lane = tid & 63, wave = tid >> 6, fr = lane & 15, fq = lane >> 4;
    const int bh = u >> 6, c = u & 63, h = bh & 3;
    LAS bf16* KTf = (LAS bf16*)lds; LAS bf16* KTb = (LAS bf16*)(lds + TILE_B); LAS bf16* VT = (LAS bf16*)(lds + 2 * TILE_B);
    const float lgf2 = log_sigmoid(dec_f[h]) * LOG2E, lgb2 = log_sigmoid(dec_b[h]) * LOG2E;
#pragma unroll
    for (int ii = 0; ii < 2; ++ii) { const int it = tid + 512 * ii, dc = it & 7, j = it >> 3;
        const u32x4 w1 = raw.k1[ii], w2 = raw.k2[ii];
        const float p = raw.p[ii];
        const float zf = fexp2(lgf2 * (float)(127 - j)) * 0.08838834764831845f, zb = fexp2(lgb2 * (float)j) * 0.08838834764831845f;
        const int jsw = (((j >> 3) ^ (dc & 7)) << 3) | (j & 7);
#pragma unroll
        for (int e = 0; e < 8; ++e) { const int i = dc * 8 + e; const float inv = fexp2(-(float)i * 0.20762050593046015f);
            float sn, cs; fast_sincos(p * inv, sn, cs);
            const float k1 = bfe(w1, e), k2 = bfe(w2, e), r1 = k1 * cs - k2 * sn, r2 = k2 * cs + k1 * sn;
            const unsigned pf = pk2(r1 * zf, r2 * zf), pb = pk2(r1 * zb, r2 * zb);
            KTf[i * LDT + jsw] = (bf16)(pf & 0xffffu); KTf[(i + 64) * LDT + jsw] = (bf16)(pf >> 16);
            KTb[i * LDT + jsw] = (bf16)(pb & 0xffffu); KTb[(i + 64) * LDT + jsw] = (bf16)(pb >> 16); }
        __builtin_amdgcn_sched_barrier(0); }
    stage_vt_regs(VT, raw, tid);
    __syncthreads();
    if (next_u >= 0) raw_load<false>(raw, next_u, PROJ, pos, tid);
    f32x4 accf[8], accb[8];
#pragma unroll
    for (int n = 0; n < 8; ++n) { accf[n] = (f32x4){0.f, 0.f, 0.f, 0.f}; accb[n] = (f32x4){0.f, 0.f, 0.f, 0.f}; }
#pragma unroll
    for (int kk = 0; kk < 4; ++kk) { const bf16x8 xf = *(const LAS bf16x8*)(VT + (wave * 16 + fr) * LDT + (((kk * 4 + fq) ^ ((2 * wave + (fr >> 3)) & 7)) << 3));
#pragma unroll
        for (int n = 0; n < 8; ++n) { const int co = (((kk * 4 + fq) ^ ((2 * n + (fr >> 3)) & 7)) << 3); const bf16x8 yf = *(const LAS bf16x8*)(KTf + (n * 16 + fr) * LDT + co); const bf16x8 yb = *(const LAS bf16x8*)(KTb + (n * 16 + fr) * LDT + co);
            accf[n] = MFMA16(yf, xf, accf[n]); accb[n] = MFMA16(yb, xf, accb[n]); } }
    bf16* of = KVc + ((size_t)bh * 64 + c) * 16384 + (wave * 16 + fr) * 128 + 4 * fq;
    bf16* ob = of + (size_t)8 * 64 * 16384;
#pragma unroll
    for (int n = 0; n < 8; ++n) { u32x2 w; w.x = pk2(accf[n][0], accf[n][1]); w.y = pk2(accf[n][2], accf[n][3]); *(u32x2*)(of + n * 16) = w;
        u32x2 v; v.x = pk2(accb[n][0], accb[n][1]); v.y = pk2(accb[n][2], accb[n][3]); *(u32x2*)(ob + n * 16) = v; }
    __syncthreads();
}

__device__ __forceinline__ void ret_unit(LAS unsigned char* lds, int u, const bf16* PROJ, const int* pos, const float* dec_f, const float* dec_b, const bf16* ST,
                                         const float* gn_w, const float* gn_b, bf16* MIX, int tid, const WsRef& wsr) {
    const int lane = tid & 63, wave = tid >> 6, fr = lane & 15, fq = lane >> 4;
    const int bh = u >> 6, c = u & 63, b = bh >> 2, h = bh & 3;
    const size_t row0 = (size_t)b * SEQ + (size_t)c * 128;
    LAS bf16* Qs = (LAS bf16*)lds; LAS bf16* Ks = (LAS bf16*)(lds + TILE_B); LAS bf16* VT = (LAS bf16*)(lds + 2 * TILE_B);
    const float lgf2 = log_sigmoid(dec_f[h]) * LOG2E, lgb2 = log_sigmoid(dec_b[h]) * LOG2E;
    const u32x4* sfp = (const u32x4*)(ST + ((size_t)bh * 64 + c) * 16384); const u32x4* sbp = (const u32x4*)(ST + ((size_t)(8 + bh) * 64 + c) * 16384);
    u32x4 sf[4], sb[4];
#pragma unroll
    for (int i = 0; i < 4; ++i) { sf[i] = sfp[tid + 512 * i]; sb[i] = sbp[tid + 512 * i]; }
    u32x4 rq1[2], rq2[2], rk1[2], rk2[2], rv[4]; float rp[2];
#pragma unroll
    for (int ii = 0; ii < 2; ++ii) { const int it = tid + 512 * ii, dc = it & 7, j = it >> 3; const unsigned qo = (unsigned)WS_PROJ + (unsigned)(((unsigned)(row0 + j) * INC + h * 128 + dc * 8) * 2u);
        rq1[ii] = ws_load16(wsr, qo); rq2[ii] = ws_load16(wsr, qo + 128u); rk1[ii] = ws_load16(wsr, qo + 1024u); rk2[ii] = ws_load16(wsr, qo + 1152u); rp[ii] = (float)pos[row0 + j]; }
#pragma unroll
    for (int ii = 0; ii < 2; ++ii) { const int it = tid + 512 * ii, dc = it & 7, j = it >> 3;
        const u32x4 q1 = rq1[ii], q2 = rq2[ii], k1 = rk1[ii], k2 = rk2[ii];
        const float p = rp[ii];
        float sn[8], cs[8];
#pragma unroll
        for (int e = 0; e < 8; ++e) { const int i = dc * 8 + e; const float inv = fexp2(-(float)i * 0.20762050593046015f); fast_sincos(p * inv, sn[e], cs[e]); }
        u32x4 oq1, oq2, ok1, ok2;
#pragma unroll
        for (int e = 0; e < 4; ++e) { const int e0 = 2 * e, e1 = 2 * e + 1;
            const float a0 = bflo(q1[e]), a1 = bfhi(q1[e]), b0 = bflo(q2[e]), b1 = bfhi(q2[e]);
            oq1[e] = pk2(a0 * cs[e0] - b0 * sn[e0], a1 * cs[e1] - b1 * sn[e1]); oq2[e] = pk2(b0 * cs[e0] + a0 * sn[e0], b1 * cs[e1] + a1 * sn[e1]);
            const float c0 = bflo(k1[e]) * 0.08838834764831845f, c1 = bfhi(k1[e]) * 0.08838834764831845f, d0 = bflo(k2[e]) * 0.08838834764831845f, d1 = bfhi(k2[e]) * 0.08838834764831845f;
            ok1[e] = pk2(c0 * cs[e0] - d0 * sn[e0], c1 * cs[e1] - d1 * sn[e1]); ok2[e] = pk2(d0 * cs[e0] + c0 * sn[e0], d1 * cs[e1] + c1 * sn[e1]); }
        *(LAS u32x4*)(Qs + j * LDT + dc * 8) = oq1; *(LAS u32x4*)(Qs + j * LDT + 64 + dc * 8) = oq2;
        *(LAS u32x4*)(Ks + j * LDT + dc * 8) = ok1; *(LAS u32x4*)(Ks + j * LDT + 64 + dc * 8) = ok2; }
#pragma unroll
    for (int ii = 0; ii < 4; ++ii) { const int it = tid + 512 * ii, ec = it & 15, j = it >> 4; rv[ii] = ws_load16(wsr, (unsigned)WS_PROJ + (unsigned)(((unsigned)(row0 + j) * INC + 1024 + h * 128 + ec * 8) * 2u)); }
#pragma unroll
    for (int ii = 0; ii < 4; ++ii) { const int it = tid + 512 * ii, ec = it & 15, j = it >> 4; const u32x4 w = rv[ii];
        const int jsw = (((j >> 3) ^ (ec & 7)) << 3) | (j & 7);
#pragma unroll
        for (int e = 0; e < 4; ++e) { VT[(ec * 8 + 2 * e) * LDT + jsw] = (bf16)(w[e] & 0xffffu); VT[(ec * 8 + 2 * e + 1) * LDT + jsw] = (bf16)(w[e] >> 16); } }
    __syncthreads();
    const int q = wave * 16 + fr;
    bf16x8 qf[4];
#pragma unroll
    for (int kk = 0; kk < 4; ++kk) qf[kk] = *(const LAS bf16x8*)(Qs + q * LDT + kk * 32 + fq * 8);
    f32x4 s[8];
#pragma unroll
    for (int n = 0; n < 8; ++n) s[n] = (f32x4){0.f, 0.f, 0.f, 0.f};
#pragma unroll
    for (int kk = 0; kk < 4; ++kk)
#pragma unroll
        for (int n = 0; n < 8; ++n) { const bf16x8 kf = *(const LAS bf16x8*)(Ks + (n * 16 + fr) * LDT + kk * 32 + fq * 8); s[n] = MFMA16(kf, qf[kk], s[n]); }
    bf16x8 pf[4];
#pragma unroll
    for (int n = 0; n < 8; ++n) {
#pragma unroll
        for (int r = 0; r < 4; ++r) { const int key = n * 16 + 4 * fq + r; const int df = q - key; const float f = df >= 0 ? fexp2(lgf2 * (float)df) : fexp2(lgb2 * (float)(-df)); s[n][r] *= f; } }
#pragma unroll
    for (int kk = 0; kk < 4; ++kk) { u32x4 w; w.x = pk2(s[2 * kk][0], s[2 * kk][1]); w.y = pk2(s[2 * kk][2], s[2 * kk][3]); w.z = pk2(s[2 * kk + 1][0], s[2 * kk + 1][1]); w.w = pk2(s[2 * kk + 1][2], s[2 * kk + 1][3]);
        pf[kk] = __builtin_bit_cast(bf16x8, w); }
    f32x4 o[8];
#pragma unroll
    for (int n = 0; n < 8; ++n) o[n] = (f32x4){0.f, 0.f, 0.f, 0.f};
#pragma unroll
    for (int kk = 0; kk < 4; ++kk)
#pragma unroll
        for (int n = 0; n < 8; ++n) { const int sw = (2 * n + (fr >> 3)) & 7, jc = kk * 4 + (fq >> 1); const LAS bf16* vr = VT + (n * 16 + fr) * LDT + 4 * (fq & 1);
            const u32x2 lo = *(const LAS u32x2*)(vr + ((jc ^ sw) << 3)), hi = *(const LAS u32x2*)(vr + (((jc + 2) ^ sw) << 3)); u32x4 w; w.x = lo.x; w.y = lo.y; w.z = hi.x; w.w = hi.y;
            o[n] = MFMA16(__builtin_bit_cast(bf16x8, w), pf[kk], o[n]); }
    __syncthreads();
#pragma unroll
    for (int i = 0; i < 4; ++i) { const int id = tid + 512 * i, e = id >> 4, dch = id & 15;
        *(LAS u32x4*)(Ks + e * LDT + dch * 8) = sf[i]; *(LAS u32x4*)(VT + e * LDT + dch * 8) = sb[i]; }
    __syncthreads();
    {
        f32x4 tf[8], tb[8];
#pragma unroll
        for (int n = 0; n < 8; ++n) { tf[n] = (f32x4){0.f, 0.f, 0.f, 0.f}; tb[n] = (f32x4){0.f, 0.f, 0.f, 0.f}; }
#pragma unroll
        for (int kk = 0; kk < 4; ++kk)
#pragma unroll
            for (int n = 0; n < 8; ++n) { const bf16x8 yf = *(const LAS bf16x8*)(Ks + (n * 16 + fr) * LDT + kk * 32 + fq * 8); const bf16x8 yb = *(const LAS bf16x8*)(VT + (n * 16 + fr) * LDT + kk * 32 + fq * 8);
                tf[n] = MFMA16(yf, qf[kk], tf[n]); tb[n] = MFMA16(yb, qf[kk], tb[n]); }
        const float xif = fexp2(lgf2 * (float)(q + 1)), xib = fexp2(lgb2 * (float)(128 - q));
#pragma unroll
        for (int n = 0; n < 8; ++n) o[n] = o[n] + tf[n] * xif + tb[n] * xib;
    }
    float sm = 0.f;
#pragma unroll
    for (int n = 0; n < 8; ++n) sm += (o[n][0] + o[n][1]) + (o[n][2] + o[n][3]);
    sm += __shfl_xor(sm, 16); sm += __shfl_xor(sm, 32);
    const float mu = sm * (1.f / 128.f);
    float vq = 0.f;
#pragma unroll
    for (int n = 0; n < 8; ++n) { const f32x4 d = o[n] - mu; vq += (d[0] * d[0] + d[1] * d[1]) + (d[2] * d[2] + d[3] * d[3]); }
    vq += __shfl_xor(vq, 16); vq += __shfl_xor(vq, 32);
    const float rstd = rsqrtf(vq * (1.f / 128.f) + EPS);
    const size_t row = row0 + q;
#pragma unroll
    for (int n = 0; n < 8; ++n) { const int col = h * 128 + n * 16 + 4 * fq;
        const f32x4 gw = *(const f32x4*)(gn_w + col), gb = *(const f32x4*)(gn_b + col);
        const u32x2 gg = *(const u32x2*)(PROJ + row * INC + 1536 + col);
        const f32x4 g = (f32x4){bflo(gg.x), bfhi(gg.x), bflo(gg.y), bfhi(gg.y)};
        f32x4 y = (o[n] - mu) * rstd * gw + gb;
#pragma unroll
        for (int r = 0; r < 4; ++r) y[r] = y[r] * g[r] * __builtin_amdgcn_rcpf(1.f + __expf(-g[r]));
        u32x2 w; w.x = pk2(y[0], y[1]); w.y = pk2(y[2], y[3]); *(u32x2*)(MIX + row * D + col) = w; }
    __syncthreads();
}

__device__ __forceinline__ void conv_unit(LAS unsigned char* lds, int u, const bf16* PROJ, const float* conv_w, const float* conv_b, const float* ln_w, const float* ln_b, bf16* MIX, int tid, const WsRef& wsr) {
    const int lane = tid & 63, wave = tid >> 6;
    LAS float* U = (LAS float*)lds;
    const int t0 = (u * 32) % SEQ; const size_t rowb = (size_t)(u * 32 / SEQ) * SEQ;
    for (int it = tid; it < 62 * 64; it += 512) { const int r = it >> 6, cc = it & 63; const int t = t0 - 15 + r;
        f32x4 u0 = (f32x4){0.f, 0.f, 0.f, 0.f}, u1 = u0;
        if (t >= 0 && t < SEQ) { const bf16* pr = PROJ + (rowb + t) * INC + 2048 + cc * 8; const u32x4 a = *(const u32x4*)pr, g = *(const u32x4*)(pr + 512);
#pragma unroll
            for (int e = 0; e < 4; ++e) { const float a0 = bflo(a[e]), a1 = bfhi(a[e]), g0 = bflo(g[e]), g1 = bfhi(g[e]);
                const float v0 = a0 * __builtin_amdgcn_rcpf(1.f + __expf(-g0)), v1 = a1 * __builtin_amdgcn_rcpf(1.f + __expf(-g1));
                if (e < 2) { u0[2 * e] = v0; u0[2 * e + 1] = v1; } else { u1[2 * e - 4] = v0; u1[2 * e - 3] = v1; } } }
        *(LAS f32x4*)(U + r * 512 + cc * 8) = u0; *(LAS f32x4*)(U + r * 512 + cc * 8 + 4) = u1; }
    float w[31];
#pragma unroll
    for (int k = 0; k < 31; ++k) w[k] = conv_w[k * 512 + tid];
    const float bias = conv_b[tid];
    __syncthreads();
    for (int tb = 0; tb < 4; ++tb) {
        float uw[38];
#pragma unroll
        for (int r = 0; r < 38; ++r) uw[r] = U[(tb * 8 + r) * 512 + tid];
        typedef float f2v __attribute__((ext_vector_type(2)));
        f2v y2[4];
#pragma unroll
        for (int t = 0; t < 4; ++t) y2[t] = (f2v){bias, bias};
#pragma unroll
        for (int k = 0; k < 31; ++k) { const f2v wk = (f2v){w[k], w[k]};
#pragma unroll
            for (int t = 0; t < 4; ++t) y2[t] = __builtin_elementwise_fma(wk, (f2v){uw[2 * t + k], uw[2 * t + k + 1]}, y2[t]); }
#pragma unroll
        for (int t = 0; t < 4; ++t) { U[(tb * 8 + 2 * t) * 512 + tid] = y2[t].x; U[(tb * 8 + 2 * t + 1) * 512 + tid] = y2[t].y; }
    }
    __syncthreads();
#pragma unroll
    for (int i = 0; i < 4; ++i) { const int tt = wave * 4 + i;
        const f32x4 a = *(const LAS f32x4*)(U + tt * 512 + lane * 8), b = *(const LAS f32x4*)(U + tt * 512 + lane * 8 + 4);
        const float mu = wave_sum((a[0] + a[1]) + (a[2] + a[3]) + (b[0] + b[1]) + (b[2] + b[3])) * (1.f / 512.f);
        const f32x4 da = a - mu, db = b - mu;
        const float var = wave_sum((da[0] * da[0] + da[1] * da[1]) + (da[2] * da[2] + da[3] * da[3]) + (db[0] * db[0] + db[1] * db[1]) + (db[2] * db[2] + db[3] * db[3])) * (1.f / 512.f);
        const float rstd = rsqrtf(var + EPS);
        const f32x4 wa = *(const f32x4*)(ln_w + lane * 8), wb = *(const f32x4*)(ln_w + lane * 8 + 4), ba = *(const f32x4*)(ln_b + lane * 8), bb = *(const f32x4*)(ln_b + lane * 8 + 4);
        f32x4 ya = da * rstd * wa + ba, yb = db * rstd * wb + bb;
#pragma unroll
        for (int e = 0; e < 4; ++e) { ya[e] = ya[e] * __builtin_amdgcn_rcpf(1.f + __expf(-ya[e])); yb[e] = yb[e] * __builtin_amdgcn_rcpf(1.f + __expf(-yb[e])); }
        u32x4 o; o.x = pk2(ya[0], ya[1]); o.y = pk2(ya[2], ya[3]); o.z = pk2(yb[0], yb[1]); o.w = pk2(yb[2], yb[3]);
        wt_store16(wsr, MIX + (rowb + t0 + tt) * D + 512 + lane * 8, o); }
    __syncthreads();
}

constexpr int LDX = 264;
__device__ __forceinline__ void xattn_unit(LAS unsigned char* lds, int u, const bf16* QO, bf16* OB, const bf16* Kx, const bf16* VTx, int tid) {
    const int lane = tid & 63, wave = tid >> 6, fr = lane & 15, fq = lane >> 4;
    const int bh = u >> 6, qt = u & 63, b = bh >> 2, h = bh & 3;
    LAS bf16* T = (LAS bf16*)lds;
    const size_t row = (size_t)b * SEQ + (size_t)qt * 128 + wave * 16 + fr;
    const bf16* qp = QO + row * D + h * 256; bf16* op = OB + row * D + h * 256;
    bf16x8 qf[8];
#pragma unroll
    for (int kk = 0; kk < 8; ++kk) qf[kk] = *(const bf16x8*)(qp + kk * 32 + fq * 8);
    const u32x4* kg = (const u32x4*)(Kx + (size_t)bh * 65536);
#pragma unroll 4
    for (int i = 0; i < 16; ++i) { const int id = tid + 512 * i, r = id >> 5, ch = id & 31; *(LAS u32x4*)(T + r * LDX + ch * 8) = kg[id]; }
    __syncthreads();
    f32x4 s[16];
#pragma unroll
    for (int n = 0; n < 16; ++n) s[n] = (f32x4){0.f, 0.f, 0.f, 0.f};
#pragma unroll
    for (int kk = 0; kk < 8; ++kk)
#pragma unroll
        for (int n = 0; n < 16; ++n) { const bf16x8 kf = *(const LAS bf16x8*)(T + (n * 16 + fr) * LDX + kk * 32 + fq * 8); s[n] = MFMA16(kf, qf[kk], s[n]); }
    float mx = -3.0e38f;
#pragma unroll
    for (int n = 0; n < 16; ++n) mx = fmaxf(mx, fmaxf(fmaxf(s[n][0], s[n][1]), fmaxf(s[n][2], s[n][3])));
    mx = fmaxf(mx, __shfl_xor(mx, 16)); mx = fmaxf(mx, __shfl_xor(mx, 32));
    const float sc = 0.0625f * LOG2E, nm = -mx * sc; float sum = 0.f;
#pragma unroll
    for (int n = 0; n < 16; ++n)
#pragma unroll
        for (int r = 0; r < 4; ++r) { const float p = fexp2(fmaf(s[n][r], sc, nm)); s[n][r] = p; sum += p; }
    sum += __shfl_xor(sum, 16); sum += __shfl_xor(sum, 32);
    const float rinv = 1.f / sum;
    bf16x8 pf[8];
#pragma unroll
    for (int kk = 0; kk < 8; ++kk) { u32x4 w; w.x = pk2(s[2 * kk][0], s[2 * kk][1]); w.y = pk2(s[2 * kk][2], s[2 * kk][3]); w.z = pk2(s[2 * kk + 1][0], s[2 * kk + 1][1]); w.w = pk2(s[2 * kk + 1][2], s[2 * kk + 1][3]);
        pf[kk] = __builtin_bit_cast(bf16x8, w); }
    __syncthreads();
    const u32x4* vg = (const u32x4*)(VTx + (size_t)bh * 65536);
#pragma unroll 4
    for (int i = 0; i < 16; ++i) { const int id = tid + 512 * i, r = id >> 5, ch = id & 31; *(LAS u32x4*)(T + r * LDX + ch * 8) = vg[id]; }
    __syncthreads();
    f32x4 o[16];
#pragma unroll
    for (int n = 0; n < 16; ++n) o[n] = (f32x4){0.f, 0.f, 0.f, 0.f};
#pragma unroll
    for (int kk = 0; kk < 8; ++kk)
#pragma unroll
        for (int n = 0; n < 16; ++n) { const LAS bf16* vp = T + (n * 16 + fr) * LDX + kk * 32 + 4 * fq;
            const u32x2 lo = *(const LAS u32x2*)vp, hi = *(const LAS u32x2*)(vp + 16); u32x4 w; w.x = lo.x; w.y = lo.y; w.z = hi.x; w.w = hi.y;
            o[n] = MFMA16(__builtin_bit_cast(bf16x8, w), pf[kk], o[n]); }
#pragma unroll
    for (int n = 0; n < 16; ++n) { const f32x4 v = o[n] * rinv; u32x2 w; w.x = pk2(v[0], v[1]); w.y = pk2(v[2], v[3]); *(u32x2*)(op + n * 16 + 4 * fq) = w; }
    __syncthreads();
}

#define XB_TMO      128
#define XB_XCNT(j)  (256  + 64 * (j))
#define XB_XSUB(j)  (1280 + 64 * (j))
#define XB_XGEN(j)  (2304 + 64 * (j))
#define XB_TOP      3328
#define XB_TOPGEN   3392
#define XCD_BAR_WORDS 3456
#define XB_SPIN_CAP (1u << 18)

__device__ __forceinline__ unsigned xb_ld(unsigned* p)              { return __hip_atomic_load(p, __ATOMIC_RELAXED, __HIP_MEMORY_SCOPE_AGENT); }
__device__ __forceinline__ unsigned xb_add(unsigned* p, unsigned v) { return __hip_atomic_fetch_add(p, v, __ATOMIC_RELAXED, __HIP_MEMORY_SCOPE_AGENT); }
__device__ __forceinline__ unsigned xb_xcc_id() { return (unsigned)__builtin_amdgcn_s_getreg((3 << 11) | 20) & 0xFu; }
#define XB_SPIN(cond, bar) do { unsigned _sp = 0; while (cond) { __builtin_amdgcn_s_sleep(1); \
    if ((++_sp & 255u) == 0u) { if (xb_ld(&(bar)[XB_TMO])) break; if (_sp > XB_SPIN_CAP) { atomicAdd(&(bar)[XB_TMO], 1u); break; } } } } while (0)

struct XcdBarrier {
    unsigned* bar; unsigned x;
    volatile LAS unsigned* st;
};

__device__ __forceinline__ XcdBarrier xcd_barrier_post(unsigned* bar, volatile LAS unsigned* st) {
    XcdBarrier b; b.bar = bar; b.x = xb_xcc_id(); b.st = st;
    if (threadIdx.x == 0) (void)xb_add(&bar[XB_XCNT(b.x)], 1u);
    return b;
}
__device__ __forceinline__ void xcd_barrier_complete(unsigned* bar, unsigned x, unsigned& nloc, unsigned& nx) {
    const unsigned G = gridDim.x * gridDim.y * gridDim.z;
    unsigned sum, cnt, mine, sp = 0u;
    for (;;) {
        sum = 0u; cnt = 0u; mine = 0u;
#pragma unroll
        for (unsigned j = 0; j < 16; ++j) { const unsigned c = xb_ld(&bar[XB_XCNT(j)]); sum += c; cnt += (c > 0u) ? 1u : 0u; mine = (j == x) ? c : mine; }
        if (sum == G) break;
        __builtin_amdgcn_s_sleep(1);
        if ((++sp & 255u) == 0u) { if (xb_ld(&bar[XB_TMO])) break; if (sp > XB_SPIN_CAP) { atomicAdd(&bar[XB_TMO], 1u); break; } }
    }
    nloc = mine > 0u ? mine : 1u; nx = cnt > 0u ? cnt : 1u;
}

__device__ __forceinline__ void xcd_barrier(const XcdBarrier& b) {
    asm volatile("s_waitcnt vmcnt(0)" ::: "memory");
    __syncthreads();
    if (threadIdx.x == 0) {
        unsigned* bar = b.bar;
        __builtin_amdgcn_s_waitcnt(0);
        unsigned nloc = b.st[0], nx = b.st[1];
        if (nloc == 0u) { xcd_barrier_complete(bar, b.x, nloc, nx); b.st[0] = nloc; b.st[1] = nx; }
        const unsigned old = xb_add(&bar[XB_XSUB(b.x)], 1u);
        const unsigned gen = old / nloc;
        if (old + 1u == (gen + 1u) * nloc) {
            __builtin_amdgcn_fence(__ATOMIC_RELEASE, "agent");
            asm volatile("s_waitcnt vmcnt(0)" ::: "memory");
            const unsigned og = xb_add(&bar[XB_TOP], 1u);
            const unsigned tg = og / nx;
            if (og + 1u == (tg + 1u) * nx) xb_add(&bar[XB_TOPGEN], 1u);
            else XB_SPIN(xb_ld(&bar[XB_TOPGEN]) == tg, bar);
            __builtin_amdgcn_fence(__ATOMIC_ACQUIRE, "agent");
            xb_add(&bar[XB_XGEN(b.x)], 1u);
            asm volatile("s_waitcnt vmcnt(0)" ::: "memory");
        } else {
            XB_SPIN(xb_ld(&bar[XB_XGEN(b.x)]) == gen, bar);
            __builtin_amdgcn_fence(__ATOMIC_ACQUIRE, "agent");
            asm volatile("s_waitcnt vmcnt(0)" ::: "memory");
        }
    }
    __syncthreads();
}


__device__ __forceinline__ void kvproj_coop(LAS unsigned char* lds, int t, const bf16* MEMN, const bf16* WXKV, bf16* Kx, bf16* VTx, int tid) {
    const int lane = tid & 63, wave = tid >> 6, fr = lane & 15, fq = lane >> 4;
    const int mt = (t >> 5) * 64, nt = (t & 31) * 64, mrow = (wave & 3) * 16, ncol = (wave >> 2) * 32;
    LAS bf16* As = (LAS bf16*)lds; LAS bf16* Bs = (LAS bf16*)(lds + 64 * 520 * 2);
    f32x4 c0 = (f32x4){0.f, 0.f, 0.f, 0.f}, c1 = c0;
    for (int kc = 0; kc < 2; ++kc) {
        u32x4 ra[8], rb[8];
#pragma unroll
        for (int i = 0; i < 8; ++i) { const int id = tid + 512 * i, r = id >> 6, ch = id & 63;
            ra[i] = *(const u32x4*)(MEMN + (size_t)(mt + r) * D + kc * 512 + ch * 8); rb[i] = *(const u32x4*)(WXKV + (size_t)(nt + r) * D + kc * 512 + ch * 8); }
        if (kc) __syncthreads();
#pragma unroll
        for (int i = 0; i < 8; ++i) { const int id = tid + 512 * i, r = id >> 6, ch = id & 63; *(LAS u32x4*)(As + r * 520 + ch * 8) = ra[i]; *(LAS u32x4*)(Bs + r * 520 + ch * 8) = rb[i]; }
        __syncthreads();
#pragma unroll
        for (int kk = 0; kk < 16; ++kk) { const bf16x8 av = *(const LAS bf16x8*)(As + (mrow + fr) * 520 + kk * 32 + fq * 8);
            const bf16x8 b0 = *(const LAS bf16x8*)(Bs + (ncol + fr) * 520 + kk * 32 + fq * 8), b1 = *(const LAS bf16x8*)(Bs + (ncol + 16 + fr) * 520 + kk * 32 + fq * 8);
            c0 = MFMA16(b0, av, c0); c1 = MFMA16(b1, av, c1); }
    }
    __syncthreads();
    const int row = mt + mrow + fr, b = row >> 8, key = row & 255;
#pragma unroll
    for (int j = 0; j < 2; ++j) { const f32x4 v = j ? c1 : c0; const int n = nt + ncol + 16 * j + 4 * fq; const bool isv = n >= 1024; const int nn = isv ? n - 1024 : n, h = nn >> 8, d = nn & 255;
        const unsigned w0 = pk2(v[0], v[1]), w1 = pk2(v[2], v[3]);
        if (!isv) { u32x2 w; w.x = w0; w.y = w1; *(u32x2*)(Kx + (size_t)(b * 4 + h) * 65536 + key * 256 + d) = w; }
        else { bf16* base = VTx + (size_t)(b * 4 + h) * 65536 + key;
            base[(d + 0) * 256] = (bf16)(w0 & 0xffffu); base[(d + 1) * 256] = (bf16)(w0 >> 16); base[(d + 2) * 256] = (bf16)(w1 & 0xffffu); base[(d + 3) * 256] = (bf16)(w1 >> 16); } }
}

__device__ __forceinline__ void xattn_softmax(f32x4 (&s)[16], bf16x8 (&pf)[8], float& rinv) {
    float mx = -3.0e38f;
#pragma unroll
    for (int n = 0; n < 16; ++n) mx = fmaxf(mx, fmaxf(fmaxf(s[n][0], s[n][1]), fmaxf(s[n][2], s[n][3])));
    mx = fmaxf(mx, __shfl_xor(mx, 16)); mx = fmaxf(mx, __shfl_xor(mx, 32));
    const float sc = 0.0625f * LOG2E, nm = -mx * sc; float sum = 0.f;
#pragma unroll
    for (int n = 0; n < 16; ++n)
#pragma unroll
        for (int r = 0; r < 4; ++r) { const float p = fexp2(fmaf(s[n][r], sc, nm)); s[n][r] = p; sum += p; }
    sum += __shfl_xor(sum, 16); sum += __shfl_xor(sum, 32);
    rinv = 1.f / sum;
#pragma unroll
    for (int kk = 0; kk < 8; ++kk) { u32x4 w; w.x = pk2(s[2 * kk][0], s[2 * kk][1]); w.y = pk2(s[2 * kk][2], s[2 * kk][3]); w.z = pk2(s[2 * kk + 1][0], s[2 * kk + 1][1]); w.w = pk2(s[2 * kk + 1][2], s[2 * kk + 1][3]);
        pf[kk] = __builtin_bit_cast(bf16x8, w); }
}
__device__ __forceinline__ void xattn_pair(LAS unsigned char* lds, int bh, size_t row_base, bf16* QO, const bf16* Kx, const bf16* VTx, int tid, const WsRef& wsr) {
    const int lane = tid & 63, wave = tid >> 6, fr = lane & 15, fq = lane >> 4, h = bh & 3;
    LAS bf16* T = (LAS bf16*)lds;
    bf16* qp0 = QO + (row_base + wave * 16 + fr) * D + h * 256; bf16* qp1 = qp0 + (size_t)128 * D;
    const u32x4* kg = (const u32x4*)(Kx + (size_t)bh * 65536);
#pragma unroll 4
    for (int i = 0; i < 16; ++i) { const int id = tid + 512 * i, r = id >> 5, ch = id & 31; *(LAS u32x4*)(T + r * LDX + ch * 8) = kg[id]; }
    __syncthreads();
    bf16x8 pf0[8], pf1[8]; float rinv0, rinv1;
#pragma unroll
    for (int half = 0; half < 2; ++half) {
        const bf16* qp = half ? qp1 : qp0;
        bf16x8 qf[8];
#pragma unroll
        for (int kk = 0; kk < 8; ++kk) qf[kk] = *(const bf16x8*)(qp + kk * 32 + fq * 8);
        f32x4 sx[16];
#pragma unroll
        for (int n = 0; n < 16; ++n) sx[n] = (f32x4){0.f, 0.f, 0.f, 0.f};
#pragma unroll
        for (int kk = 0; kk < 8; ++kk)
#pragma unroll
            for (int n = 0; n < 16; ++n) { const bf16x8 kf = *(const LAS bf16x8*)(T + (n * 16 + fr) * LDX + kk * 32 + fq * 8); sx[n] = MFMA16(kf, qf[kk], sx[n]); }
        if (half == 0) xattn_softmax(sx, pf0, rinv0); else xattn_softmax(sx, pf1, rinv1);
        __builtin_amdgcn_sched_barrier(0);
    }
    __syncthreads();
    const u32x4* vg = (const u32x4*)(VTx + (size_t)bh * 65536);
#pragma unroll 4
    for (int i = 0; i < 16; ++i) { const int id = tid + 512 * i, r = id >> 5, ch = id & 31; *(LAS u32x4*)(T + r * LDX + ch * 8) = vg[id]; }
    __syncthreads();
#pragma unroll
    for (int nh = 0; nh < 2; ++nh) {
        f32x4 o0[8], o1[8];
#pragma unroll
        for (int n = 0; n < 8; ++n) { o0[n] = (f32x4){0.f, 0.f, 0.f, 0.f}; o1[n] = (f32x4){0.f, 0.f, 0.f, 0.f}; }
#pragma unroll
        for (int kk = 0; kk < 8; ++kk)
#pragma unroll
            for (int n = 0; n < 8; ++n) { const LAS bf16* vp = T + ((nh * 8 + n) * 16 + fr) * LDX + kk * 32 + 4 * fq;
                const u32x2 lo = *(const LAS u32x2*)vp, hi = *(const LAS u32x2*)(vp + 16); u32x4 w; w.x = lo.x; w.y = lo.y; w.z = hi.x; w.w = hi.y; const bf16x8 vf = __builtin_bit_cast(bf16x8, w);
                o0[n] = MFMA16(vf, pf0[kk], o0[n]); o1[n] = MFMA16(vf, pf1[kk], o1[n]); }
#pragma unroll
        for (int n = 0; n < 8; ++n) { const f32x4 v0 = o0[n] * rinv0, v1 = o1[n] * rinv1; u32x2 w0, w1; w0.x = pk2(v0[0], v0[1]); w0.y = pk2(v0[2], v0[3]); w1.x = pk2(v1[0], v1[1]); w1.y = pk2(v1[2], v1[3]);
            wt_store8(wsr, qp0 + (nh * 8 + n) * 16 + 4 * fq, w0); wt_store8(wsr, qp1 + (nh * 8 + n) * 16 + 4 * fq, w1); }
        __builtin_amdgcn_sched_barrier(0);
    }
    __syncthreads();
}

__device__ __forceinline__ void panel_barrier(unsigned* cnt, bool release) {
    asm volatile("s_waitcnt vmcnt(0)" ::: "memory");
    __syncthreads();
    if (threadIdx.x == 0) {
        if (release) { __builtin_amdgcn_fence(__ATOMIC_RELEASE, "agent"); asm volatile("s_waitcnt vmcnt(0)" ::: "memory"); }
        __hip_atomic_fetch_add(cnt, 1u, __ATOMIC_RELAXED, __HIP_MEMORY_SCOPE_AGENT);
        unsigned spins = 0;
        while (__hip_atomic_load(cnt, __ATOMIC_RELAXED, __HIP_MEMORY_SCOPE_AGENT) < 4u) { __builtin_amdgcn_s_sleep(1); if (++spins > (1u << 22)) break; }
        __builtin_amdgcn_fence(__ATOMIC_ACQUIRE, "agent");
        asm volatile("s_waitcnt vmcnt(0)" ::: "memory");
    }
    __syncthreads();
}
__device__ __forceinline__ void local_rw_sync() {
    asm volatile("s_waitcnt vmcnt(0)" ::: "memory");
    __syncthreads();
    if (threadIdx.x == 0) { __builtin_amdgcn_fence(__ATOMIC_ACQUIRE, "agent"); asm volatile("s_waitcnt vmcnt(0)" ::: "memory"); }
    __syncthreads();
}
struct Args { const float* in[23]; float* out; unsigned char* ws; int ph_lo, ph_hi; };
__global__ void __launch_bounds__(512, 2) fwd_mega(Args a) {
    extern __shared__ __attribute__((aligned(16))) unsigned char lds_raw[];
    LAS unsigned char* lds = (LAS unsigned char*)lds_raw;
    cg::grid_group grid = cg::this_grid();
    const int tid = threadIdx.x, lane = tid & 63, wave = __builtin_amdgcn_readfirstlane(tid >> 6);
    const int G = gridDim.x, bid = blockIdx.x;
    const int lo = a.ph_lo, hi = a.ph_hi;
#define IN(k) (lo <= (k) && (k) < hi)
#ifndef DUP_MASK
#define DUP_MASK 0
#endif
#define REP(k) for (int rep_ = 0; rep_ < 1 + ((DUP_MASK >> (k)) & 1); ++rep_)
#define SEAM(k) do { if (IN(k) && IN((k) + 1)) xcd_barrier(bar); } while (0)
    volatile LAS unsigned* MISC = (volatile LAS unsigned*)(lds + MISC_OFF);
    if (tid < 16) MISC[tid] = 0u;
    __syncthreads();
    if (lo < 0) grid.sync();
    XcdBarrier bar = xcd_barrier_post((unsigned*)(a.ws + WS_CTL) + 1024, MISC + 8);
    unsigned char* ws = a.ws;
    WsRef wsr; wsr.r = __builtin_amdgcn_make_buffer_rsrc((void*)a.ws, (short)0, 0x10000000, 0x00020000); wsr.base = a.ws;
    const float* x = a.in[0]; const float* mem = a.in[1]; const int* pos = (const int*)a.in[2];
    bf16* WIN = (bf16*)(ws + WS_WIN); bf16* WOUT = (bf16*)(ws + WS_WOUT); bf16* WXQ = (bf16*)(ws + WS_WXQ); bf16* WXKV = (bf16*)(ws + WS_WXKV);
    bf16* WXO = (bf16*)(ws + WS_WXO); bf16* WFF1 = (bf16*)(ws + WS_WFF1); bf16* WFF2 = (bf16*)(ws + WS_WFF2);
    bf16* MEMN = (bf16*)(ws + WS_MEMN); bf16* KX = (bf16*)(ws + WS_KX); bf16* VTX = (bf16*)(ws + WS_VTX);
    bf16* H = (bf16*)(ws + WS_H); bf16* ST = (bf16*)a.out;     bf16* MIX = (bf16*)(ws + WS_MIX); bf16* QO = (bf16*)(ws + WS_QO); bf16* KVC = (bf16*)(ws + WS_QO);
    bf16* PROJ = (bf16*)(ws + WS_PROJ); bf16* F = (bf16*)(ws + WS_F);
    float* out = a.out; float* RSQ0 = (float*)(ws + WS_CTL + 65536); float* RSQ1 = (float*)(ws + WS_CTL + 131072); float* RSQ2 = (float*)(ws + WS_CTL + 196608); float* RSQX = (float*)(ws + WS_CTL + 524288);
    const int gw = bid * 8 + wave, NGW = G * 8;

    if (IN(0)) REP(0) {
        LAS float* scr = (LAS float*)(lds + wave * 16896);
        constexpr int I_IN = 16 * 48, I_KV = 16 * 32;
        constexpr int NIT = I_IN + I_KV;
        for (int it = gw; it < NIT; it += NGW) { int r = it;
            if (r < I_IN) { p0_transpose_item64(wsr, a.in[4], D, INC, WIN, scr, r, lane, a.in[3]); continue; } r -= I_IN;
            p0_transpose_item64(wsr, a.in[17], D, 2 * D, WXKV, scr, r, lane); }
        for (int m = gw; m < M; m += 2 * NGW) {
            const int m2 = (m + NGW < M) ? m + NGW : m;
            const f32x4* xr0 = (const f32x4*)(x + (size_t)m * D) + 2 * lane; const f32x4* xr1 = (const f32x4*)(x + (size_t)m2 * D) + 2 * lane;
            f32x4 v0[4], v1[4]; float s0 = 0.f, s1 = 0.f;
#pragma unroll
            for (int j = 0; j < 2; ++j) { v0[2 * j] = xr0[128 * j]; v0[2 * j + 1] = xr0[128 * j + 1]; v1[2 * j] = xr1[128 * j]; v1[2 * j + 1] = xr1[128 * j + 1]; }
#pragma unroll
            for (int j = 0; j < 4; ++j) { s0 += (v0[j].x * v0[j].x + v0[j].y * v0[j].y) + (v0[j].z * v0[j].z + v0[j].w * v0[j].w); s1 += (v1[j].x * v1[j].x + v1[j].y * v1[j].y) + (v1[j].z * v1[j].z + v1[j].w * v1[j].w); }
#pragma unroll
            for (int o = 1; o < 64; o <<= 1) { s0 += __shfl_xor(s0, o); s1 += __shfl_xor(s1, o); }
            if (lane == 0) { RSQX[m] = s0; RSQX[m2] = s1; }
            bf16* o0 = H + (size_t)m * D + 8 * lane; bf16* o1 = H + (size_t)m2 * D + 8 * lane;
#pragma unroll
            for (int j = 0; j < 2; ++j) { const f32x4 a0 = v0[2 * j], b0 = v0[2 * j + 1], a1 = v1[2 * j], b1 = v1[2 * j + 1];
                u32x4 p0, p1; p0.x = pk2(a0.x, a0.y); p0.y = pk2(a0.z, a0.w); p0.z = pk2(b0.x, b0.y); p0.w = pk2(b0.z, b0.w); p1.x = pk2(a1.x, a1.y); p1.y = pk2(a1.z, a1.w); p1.z = pk2(b1.x, b1.y); p1.w = pk2(b1.z, b1.w);
                wt_store16(wsr, o0 + 512 * j, p0); if (m2 != m) wt_store16(wsr, o1 + 512 * j, p1); }
        }
        for (int m = gw; m < BATCH * 256; m += NGW) rms_row_to_bf16(mem + (size_t)m * D, a.in[15], MEMN + (size_t)m * D, lane);
        __syncthreads();
    }
    SEAM(0);
    if (IN(1)) REP(1) {
        { pg8::Gemm g{H, WIN, M, INC, D}; pg8::StaticOrder S; S.init(M, INC, G, bid); pg8::EpiBf16<0> E{PROJ, INC, RSQX};
          pg8::gemm_phase<pg8::EpiBf16<0>, pg8::StaticOrder, true, true>(lds, g, S, E); }
    }
    SEAM(1);
    if (IN(2)) REP(2) {
        { UnitRaw raw; int u = bid; if (u < 512) raw_load<false>(raw, u, PROJ, pos, tid);
          for (; u < 512; u += G) kv_unit(lds, u, PROJ, pos, a.in[5], a.in[6], KVC, tid, raw, (u + G < 512) ? u + G : -1); }
        for (int u = bid; u < 512; u += G) conv_unit(lds, u, PROJ, a.in[9], a.in[10], a.in[11], a.in[12], MIX, tid, wsr);
    }
    SEAM(2);
    if (IN(3)) REP(3) {
        for (int t = bid; t < 256; t += G) kvproj_coop(lds, t, MEMN, WXKV, KX, VTX, tid);
        const int sb = bid, sG = G;
        if (sb >= 0) {
            LAS float* scr = (LAS float*)(lds + wave * 16896);
            constexpr int I_SQ = 16 * 16, I_F1 = 16 * 64, I_F2 = 64 * 16, NIT3 = 3 * I_SQ + I_F1 + I_F2;
            for (int it = sb * 8 + wave; it < NIT3; it += sG * 8) { int r = it;
                if (r < I_SQ) { p0_transpose_item64(wsr, a.in[13], D, D, WOUT, scr, r, lane); continue; } r -= I_SQ;
                if (r < I_SQ) { p0_transpose_item64(wsr, a.in[16], D, D, WXQ, scr, r, lane, a.in[14]); continue; } r -= I_SQ;
                if (r < I_SQ) { p0_transpose_item64(wsr, a.in[18], D, D, WXO, scr, r, lane); continue; } r -= I_SQ;
                if (r < I_F1) { p0_transpose_item64(wsr, a.in[20], D, FF, WFF1, scr, r, lane, a.in[19]); continue; } r -= I_F1;
                p0_transpose_item64(wsr, a.in[21], FF, D, WFF2, scr, r, lane); }
        }
        if (sb >= 0)
        for (int idx = sb * 512 + tid; idx < 131072; idx += sG * 512) {
            const int p = idx & 8191, bh = (idx >> 13) & 7, dir = idx >> 16, h = bh & 3;
            const float lg = log_sigmoid(dir ? a.in[6][h] : a.in[5][h]); const float dec = expf(lg * 128.f);
            const size_t base = (size_t)(dir * 8 + bh) * 64 * 16384 + (size_t)p * 2;
            const bf16* kv = KVC + base; bf16* st = ST + base;
            float s0 = 0.f, s1 = 0.f;
            const unsigned* kvw = (const unsigned*)kv; unsigned* stw = (unsigned*)st;
            for (int c0 = 0; c0 < 64; c0 += 16) {
                unsigned w[16];
#pragma unroll
                for (int i = 0; i < 16; ++i) { const int cc = dir ? 63 - (c0 + i) : c0 + i; w[i] = kvw[(size_t)cc * 8192]; }
#pragma unroll
                for (int i = 0; i < 16; ++i) { const int cc = dir ? 63 - (c0 + i) : c0 + i; stw[(size_t)cc * 8192] = pk2(s0, s1); s0 = fmaf(dec, s0, bflo(w[i])); s1 = fmaf(dec, s1, bfhi(w[i])); }
            }
        }
    }
    SEAM(3);
    if (IN(4)) REP(4) {
        for (int u = bid; u < 512; u += G) ret_unit(lds, u, PROJ, pos, a.in[5], a.in[6], ST, a.in[7], a.in[8], MIX, tid, wsr);
    }
    SEAM(4);
    const bool panel_mode = (G == 256);
    pg8::Unit myu; { pg8::StaticOrder S; S.init(M, D, G, bid); if (!S.next(0, myu)) { myu.pm = 0; myu.pn = 0; } }
    unsigned* pbar = (unsigned*)(ws + WS_CTL + 327680) + 64 * myu.pm;
#define PSEAM(k, idx, rel) do { if (IN(k) && IN((k) + 1)) { if (panel_mode) panel_barrier(pbar + (idx) * 4096, rel); else xcd_barrier(bar); } } while (0)
    if (IN(5)) {
        pg8::Gemm g{MIX, WOUT, M, D, D}; pg8::StaticOrder S; S.init(M, D, G, bid); pg8::EpiResidual<1> E{nullptr, H, nullptr, D, RSQ0};
        pg8::gemm_phase<pg8::EpiResidual<1>, pg8::StaticOrder, true, true>(lds, g, S, E);
    }
    PSEAM(5, 0, false);
    if (IN(7)) REP(7) {
        pg8::Gemm g{H, WXQ, M, D, D}; pg8::StaticOrder S; S.init(M, D, G, bid); pg8::EpiBf16<0> E{MIX, D, RSQ0};
        pg8::gemm_phase<pg8::EpiBf16<0>, pg8::StaticOrder, true, true>(lds, g, S, E);
    }
    if (IN(7) && IN(8)) { if (panel_mode) local_rw_sync(); else xcd_barrier(bar); }
    if (IN(8)) {
        if (panel_mode) { const int bh = (myu.pm >> 5) * 4 + myu.pn;
            xattn_pair(lds, bh, (size_t)myu.pm * 256, MIX, KX, VTX, tid, wsr); }
        else { for (int u = bid; u < 512; u += G) xattn_unit(lds, u, MIX, MIX, KX, VTX, tid); }
    }
    PSEAM(8, 1, !panel_mode);
    if (IN(9)) {
        pg8::Gemm g{MIX, WXO, M, D, D}; pg8::StaticOrder S; S.init(M, D, G, bid); pg8::EpiResidual<1> E{nullptr, H, nullptr, D, RSQ1};
        pg8::gemm_phase<pg8::EpiResidual<1>, pg8::StaticOrder, true, true>(lds, g, S, E);
    }
    PSEAM(9, 2, false);
    if (IN(11)) REP(11) {
        pg8::Gemm g{H, WFF1, M, FF, D}; pg8::StaticOrder S; S.init(M, FF, G, bid); pg8::EpiBf16<1> E{F, FF, RSQ1};
        pg8::gemm_phase<pg8::EpiBf16<1>, pg8::StaticOrder, true, true>(lds, g, S, E);
    }
    PSEAM(11, 3, false);
    const bool fuse_final = (G == 256);
    if (IN(12)) {
        pg8::Gemm g{F, WFF2, M, D, FF}; pg8::StaticOrder S; S.init(M, D, G, bid);
        if (fuse_final) { pg8::EpiFinalNorm E{H, out, D, a.in[22], RSQ2, (unsigned*)(ws + WS_CTL + 262144)};
            pg8::gemm_phase<pg8::EpiFinalNorm, pg8::StaticOrder, false, true>(lds, g, S, E); }
        else { pg8::EpiResidual<2> E{nullptr, H, out, D, nullptr};
            pg8::gemm_phase<pg8::EpiResidual<2>, pg8::StaticOrder, true, true>(lds, g, S, E); }
    }
    if (!fuse_final) {
        SEAM(12);
        if (IN(13)) { for (int m = gw; m < M; m += NGW) rms_row_to_f32(out + (size_t)m * D, a.in[22], out + (size_t)m * D, lane); }
    }
#undef IN
#undef SEAM
}

extern "C" void kernel_launch(void* const* d_in, const int* in_sizes, int n_in, void* d_out, int out_size, void* d_ws, size_t ws_size, hipStream_t stream) {
    static int grid = 0;
    if (grid == 0) {
        if (n_in != 23 || out_size != M * D || ws_size < WS_END) { fprintf(stderr, "kernel_launch: unexpected problem (n_in %d out %d ws %zu)\n", n_in, out_size, ws_size); grid = -1; return; }
        int dev = 0, cus = 0, per_cu = 0;
        (void)hipGetDevice(&dev); (void)hipDeviceGetAttribute(&cus, hipDeviceAttributeMultiprocessorCount, dev);
        if (hipFuncSetAttribute((const void*)fwd_mega, hipFuncAttributeMaxDynamicSharedMemorySize, LDS_BYTES) != hipSuccess) { fprintf(stderr, "kernel_launch: hipFuncSetAttribute failed\n"); grid = -1; return; }
        if (hipOccupancyMaxActiveBlocksPerMultiprocessor(&per_cu, (const void*)fwd_mega, 512, LDS_BYTES) != hipSuccess || per_cu < 1) { fprintf(stderr, "kernel_launch: occupancy query says %d\n", per_cu); per_cu = 1; }
        (void)hipGetLastError();
        grid = cus * per_cu;
        if (grid <= 0) grid = 256;
    }
    if (grid < 0) return;
    if (hipMemsetAsync((char*)d_ws + WS_CTL, 0, CTL_ZERO_BYTES, stream) != hipSuccess) { fprintf(stderr, "kernel_launch: memset failed\n"); return; }
    Args a{};
    for (int i = 0; i < 23; ++i) a.in[i] = (const float*)d_in[i];
    a.out = (float*)d_out; a.ws = (unsigned char*)d_ws;
#if MK_N_LAUNCHES == 1
    a.ph_lo = 0; a.ph_hi = NPH;
    void* args[] = {&a};
    hipError_t e = hipLaunchCooperativeKernel((const void*)fwd_mega, dim3(grid), dim3(512), args, LDS_BYTES, stream);
    if (e != hipSuccess) fprintf(stderr, "cooperative launch failed: %s (grid %d)\n", hipGetErrorString(e), grid);
#else
    for (int p = 0; p < NPH; ++p) { a.ph_lo = p; a.ph_hi = p + 1; hipLaunchKernelGGL(fwd_mega, dim3(grid), dim3(512), LDS_BYTES, stream, a); }
#endif
}
```

```cpp
#include <hip/hip_runtime.h>
#include <hip/hip_cooperative_groups.h>
#include <cstdio>
#include <cstdint>
namespace cg = cooperative_groups;
namespace pg8 {
#define PG8_LAS __attribute__((address_space(3)))
typedef unsigned short bf16_t;
typedef short bf16x8 __attribute__((ext_vector_type(8)));
typedef float f32x4 __attribute__((ext_vector_type(4)));
typedef unsigned u32x4 __attribute__((ext_vector_type(4)));
constexpr int BM = 256, BK = 64, HALF = 128, HTB = HALF * BK * 2  , STAGE_BYTES = 8 * HTB, NXCD = 8, WGM = 8;

__host__ __device__ __forceinline__ int lds_byte(int r, int c) { const int st = (r >> 4) * 2 + (c >> 5), rr = r & 15, cc = c & 31, ob = rr * 64 + cc * 2; return st * 1024 + (ob ^ (((ob >> 9) & 1) << 5)); }
__host__ __device__ __forceinline__ void stage_rc(int b, int& R, int& C) { const int st = b / 1024, sb = b % 1024, swz = sb ^ (((sb >> 9) & 1) << 5); R = (st >> 1) * 16 + swz / 64; C = (st & 1) * 32 + (swz % 64) / 2; }
__host__ __device__ __forceinline__ int perm32(int rho) { const int n = rho >> 4, i = rho & 15; return 8 * (i >> 2) + 4 * n + (i & 3); }

struct Unit { int pm, pn; };
struct Gemm { const bf16_t* A; const bf16_t* Bt; int M, N, K; };

struct StaticOrder {
    int nM, nN, nwg, G, c;
    __host__ __device__ void init(int M, int N, int G_, int c_) { nM = M / BM; nN = N / BM; nwg = nM * nN; G = G_; c = c_; }
    __host__ __device__ bool next(int i, Unit& u) const {
        const long L = (long)i * G + c; if (L >= nwg) return false;
        int wgid = (int)L; { const int q = nwg / NXCD, r = nwg % NXCD, xcd = wgid % NXCD, off = wgid / NXCD; wgid = (xcd < r ? xcd * (q + 1) : r * (q + 1) + (xcd - r) * q) + off; }
        const int nig = WGM * nN, gid = wgid / nig, fm = gid * WGM, gsz = (nM - fm) < WGM ? (nM - fm) : WGM;
        u.pm = fm + ((wgid % nig) % gsz); u.pn = (wgid % nig) / gsz; return true;
    }
    __device__ __forceinline__ void a_ready(const Unit&) const {}
    __device__ __forceinline__ void done(const Unit&) const {}
};

typedef float f32x2_t __attribute__((ext_vector_type(2)));
typedef __bf16 bf16x2_t __attribute__((ext_vector_type(2)));
__device__ __forceinline__ unsigned cvt_pk_bf16(float lo, float hi) { f32x2_t v = {lo, hi}; bf16x2_t b = __builtin_convertvector(v, bf16x2_t); return __builtin_bit_cast(unsigned, b); }
typedef float f32x2 __attribute__((ext_vector_type(2)));
typedef unsigned u32x2 __attribute__((ext_vector_type(2)));
template <int ACT> struct EpiBf16 {
    static constexpr bool PERM = true, AFTER_DRAIN = false;
    bf16_t* O; int ldc; const float* rowsq;
    __device__ __forceinline__ void operator()(const f32x4 (&acc)[2][2][4][2], const Unit& u, int wr, int wc, int fr, int fq) const {
        const int row0 = u.pm * BM + wr * 64 + fr; const int col0 = u.pn * BM + wc * 32 + 8 * fq;
        const __amdgpu_buffer_rsrc_t rsrc = __builtin_amdgcn_make_buffer_rsrc((void*)O, (short)0, 16384 * ldc * 2, 0x00020000);
#pragma unroll
        for (int ai = 0; ai < 2; ++ai)
#pragma unroll
            for (int m = 0; m < 4; ++m) { const int row = row0 + ai * HALF + m * 16;
                const float rs = rowsq ? rsqrtf(rowsq[row] * (1.0f / 1024.0f) + 1e-6f) : 1.0f;
#pragma unroll
                for (int bj = 0; bj < 2; ++bj) { f32x4 v0 = acc[ai][bj][m][0] * rs, v1 = acc[ai][bj][m][1] * rs;
                    if (ACT == 1) {
#pragma unroll
                        for (int e = 0; e < 4; ++e) { const float a0 = fmaxf(v0[e], 0.f), a1 = fmaxf(v1[e], 0.f); v0[e] = a0 * a0; v1[e] = a1 * a1; } }
                    u32x4 w; w.x = cvt_pk_bf16(v0[0], v0[1]); w.y = cvt_pk_bf16(v0[2], v0[3]); w.z = cvt_pk_bf16(v1[0], v1[1]); w.w = cvt_pk_bf16(v1[2], v1[3]);
                    __builtin_amdgcn_raw_buffer_store_b128(w, rsrc, (unsigned)(((size_t)row * ldc + col0 + bj * HALF) * 2), 0,   16); } }
    }
};
template <int MODE> struct EpiResidual {
    static constexpr bool PERM = true, AFTER_DRAIN = false;
    const float* basef; bf16_t* xb; float* outf; int ldc; float* rowsq;
    __device__ __forceinline__ void operator()(const f32x4 (&acc)[2][2][4][2], const Unit& u, int wr, int wc, int fr, int fq) const {
        const int col0 = u.pn * BM + wc * 32 + 8 * fq;
        const __amdgpu_buffer_rsrc_t rsrc = __builtin_amdgcn_make_buffer_rsrc((void*)xb, (short)0, 16384 * 1024 * 2, 0x00020000);
#pragma unroll
        for (int ai = 0; ai < 2; ++ai)
#pragma unroll
            for (int m = 0; m < 4; ++m) { const int row = u.pm * BM + ai * HALF + wr * 64 + m * 16 + fr; const size_t off = (size_t)row * ldc + col0; float ss = 0.f;
#pragma unroll
                for (int bj = 0; bj < 2; ++bj) { const size_t o2 = off + bj * HALF; f32x4 b0, b1;
                    if (MODE == 0) { b0 = *(const f32x4*)(basef + o2); b1 = *(const f32x4*)(basef + o2 + 4); }
                    else { const u32x4 w = *(const u32x4*)(xb + o2);
                        b0 = (f32x4){__uint_as_float(w.x << 16), __uint_as_float(w.x & 0xffff0000u), __uint_as_float(w.y << 16), __uint_as_float(w.y & 0xffff0000u)};
                        b1 = (f32x4){__uint_as_float(w.z << 16), __uint_as_float(w.z & 0xffff0000u), __uint_as_float(w.w << 16), __uint_as_float(w.w & 0xffff0000u)}; }
                    const f32x4 v0 = b0 + acc[ai][bj][m][0], v1 = b1 + acc[ai][bj][m][1];
                    if (MODE == 2) { *(f32x4*)(outf + o2) = v0; *(f32x4*)(outf + o2 + 4) = v1; }
                    else { ss += (v0[0] * v0[0] + v0[1] * v0[1]) + (v0[2] * v0[2] + v0[3] * v0[3]) + (v1[0] * v1[0] + v1[1] * v1[1]) + (v1[2] * v1[2] + v1[3] * v1[3]);
                        u32x4 w; w.x = cvt_pk_bf16(v0[0], v0[1]); w.y = cvt_pk_bf16(v0[2], v0[3]); w.z = cvt_pk_bf16(v1[0], v1[1]); w.w = cvt_pk_bf16(v1[2], v1[3]);
                        __builtin_amdgcn_raw_buffer_store_b128(w, rsrc, (unsigned)(o2 * 2), 0, 16); } }
                if (MODE != 2) { ss += __shfl_xor(ss, 16); ss += __shfl_xor(ss, 32); if (fq == 0) atomicAdd(rowsq + row, ss); } }
    }
};
struct EpiFinalNorm {
    static constexpr bool PERM = false, AFTER_DRAIN = true;
    const bf16_t* xb; float* outf; int ldc; const float* nw; float* rowsq; unsigned* cnt;
    __device__ __forceinline__ void fused(f32x4 (&acc)[2][2][4][2], const Unit& u, int wr, int wc, int fr, int fq, PG8_LAS unsigned char* lds, int wid, int lane) const {
        const int col0 = u.pn * BM + wc * 32 + 4 * fq;
#pragma unroll
        for (int ai = 0; ai < 2; ++ai)
#pragma unroll
            for (int m = 0; m < 4; ++m) { const int row = u.pm * BM + ai * HALF + wr * 64 + m * 16 + fr; const size_t off = (size_t)row * ldc + col0; float ss = 0.f;
#pragma unroll
                for (int bj = 0; bj < 2; ++bj)
#pragma unroll
                    for (int n = 0; n < 2; ++n) { const u32x2 w = *(const u32x2*)(xb + off + bj * HALF + n * 16);
                        const f32x4 bs = (f32x4){__uint_as_float(w.x << 16), __uint_as_float(w.x & 0xffff0000u), __uint_as_float(w.y << 16), __uint_as_float(w.y & 0xffff0000u)};
                        const f32x4 v = bs + acc[ai][bj][m][n]; acc[ai][bj][m][n] = v; ss += (v[0] * v[0] + v[1] * v[1]) + (v[2] * v[2] + v[3] * v[3]); }
                ss += __shfl_xor(ss, 16); ss += __shfl_xor(ss, 32); if (fq == 0) atomicAdd(rowsq + row, ss); }
        asm volatile("s_waitcnt vmcnt(0)" ::: "memory");
        __syncthreads();
        if (threadIdx.x == 0) {
            unsigned* c = cnt + 64 * u.pm;
            __hip_atomic_fetch_add(c, 1u, __ATOMIC_RELAXED, __HIP_MEMORY_SCOPE_AGENT);
            unsigned spins = 0;
            while (__hip_atomic_load(c, __ATOMIC_RELAXED, __HIP_MEMORY_SCOPE_AGENT) < 4u) { __builtin_amdgcn_s_sleep(1); if (++spins > (1u << 22)) break; }
        }
        __syncthreads();
        const __amdgpu_buffer_rsrc_t orsrc = __builtin_amdgcn_make_buffer_rsrc((void*)outf, (short)0, 16384 * 1024 * 4, 0x00020000);
        f32x4 nwv[2][2];
#pragma unroll
        for (int bj = 0; bj < 2; ++bj)
#pragma unroll
            for (int n = 0; n < 2; ++n) nwv[bj][n] = *(const f32x4*)(nw + col0 + bj * HALF + n * 16);
#pragma unroll
        for (int ai = 0; ai < 2; ++ai)
#pragma unroll
            for (int m = 0; m < 4; ++m) { const int row = u.pm * BM + ai * HALF + wr * 64 + m * 16 + fr; const size_t off = (size_t)row * ldc + col0;
                const float rs = rsqrtf(__hip_atomic_load(rowsq + row, __ATOMIC_RELAXED, __HIP_MEMORY_SCOPE_AGENT) * (1.0f / 1024.0f) + 1e-6f);
#pragma unroll
                for (int bj = 0; bj < 2; ++bj)
#pragma unroll
                    for (int n = 0; n < 2; ++n) { const f32x4 y = acc[ai][bj][m][n] * rs * nwv[bj][n]; __builtin_amdgcn_raw_buffer_store_b128(__builtin_bit_cast(u32x4, y), orsrc, (unsigned)((off + bj * HALF + n * 16) * 4), 0, 16); } }
    }
};
struct EpiKV {
    static constexpr bool PERM = false, AFTER_DRAIN = true;
    bf16_t* Kx; bf16_t* VTx;
    __device__ __forceinline__ void fused(f32x4 (&acc)[2][2][4][2], const Unit& u, int wr, int wc, int fr, int fq, PG8_LAS unsigned char* lds, int wid, int lane) const {
        const bool isv = u.pn >= 4; const int h = isv ? u.pn - 4 : u.pn;
        bf16_t* base = (isv ? VTx : Kx) + (size_t)(u.pm * 4 + h) * 65536;
        const int col0 = wc * 32 + 4 * fq;
        if (!isv) {
#pragma unroll
            for (int ai = 0; ai < 2; ++ai)
#pragma unroll
                for (int m = 0; m < 4; ++m) { const int key = ai * HALF + wr * 64 + m * 16 + fr;
#pragma unroll
                    for (int bj = 0; bj < 2; ++bj)
#pragma unroll
                        for (int n = 0; n < 2; ++n) { const f32x4 v = acc[ai][bj][m][n]; const int c = col0 + bj * HALF + n * 16;
                            u32x2 w; w.x = cvt_pk_bf16(v[0], v[1]); w.y = cvt_pk_bf16(v[2], v[3]); *(u32x2*)(base + (size_t)key * 256 + c) = w; } }
        } else {
            PG8_LAS bf16_t* T = (PG8_LAS bf16_t*)lds;
#pragma unroll
            for (int ai = 0; ai < 2; ++ai)
#pragma unroll
                for (int m = 0; m < 4; ++m) { const int key = ai * HALF + wr * 64 + m * 16 + fr;
#pragma unroll
                    for (int bj = 0; bj < 2; ++bj)
#pragma unroll
                        for (int n = 0; n < 2; ++n) { const f32x4 v = acc[ai][bj][m][n]; const int c = col0 + bj * HALF + n * 16;
                            const unsigned w0 = cvt_pk_bf16(v[0], v[1]), w1 = cvt_pk_bf16(v[2], v[3]);
                            T[(c + 0) * 264 + key] = (bf16_t)(w0 & 0xffffu); T[(c + 1) * 264 + key] = (bf16_t)(w0 >> 16); T[(c + 2) * 264 + key] = (bf16_t)(w1 & 0xffffu); T[(c + 3) * 264 + key] = (bf16_t)(w1 >> 16); } }
            __syncthreads();
            const int tid = wid * 64 + lane;
#pragma unroll 4
            for (int i = 0; i < 16; ++i) { const int id = tid + 512 * i, r = id >> 5, ch = id & 31; *(u32x4*)(base + (size_t)r * 256 + ch * 8) = *(const PG8_LAS u32x4*)(T + r * 264 + ch * 8); }
        }
    }
};

template <class Epi, class Sched, bool ALIGN_EPI = false, bool SP2 = false>
__device__ __forceinline__ void gemm_phase(PG8_LAS unsigned char* lds, const Gemm g, const Sched& S, const Epi& E) {
    const int tid = threadIdx.x, wid = __builtin_amdgcn_readfirstlane(tid >> 6), lane = tid & 63, wr = wid >> 2, wc = wid & 3, fr = lane & 15, fq = lane >> 4;
    const int K = g.K, nt = K / BK;
    unsigned voffA[2], voffB[2];
#pragma unroll
    for (int i = 0; i < 2; ++i) { int R, C; stage_rc(tid * 16 + i * 8192, R, C); const int Rb = Epi::PERM ? ((R & ~31) + perm32(R & 31)) : R;
        voffA[i] = (unsigned)(R * K + C) * 2u; voffB[i] = (unsigned)(Rb * K + C) * 2u; }
    const size_t kstep = (size_t)(BK * 2);
    const size_t hstep = (size_t)HALF * K * 2;
    const size_t tstep = 2 * hstep;
    const unsigned ldsw = (unsigned)wid * 1024u;
    const int aoff = lds_byte(wr * 64 + fr, fq * 8), boff = lds_byte(wc * 32 + fr, fq * 8);
#define PG8_SA(b, h) (((b) * 2 + (h)) * HTB)
#define PG8_SB(b, h) ((4 + (b) * 2 + (h)) * HTB)
#define PG8_STAGE(bufoff, gbase, voff) do { _Pragma("unroll") for (int _i = 0; _i < 2; ++_i) \
        __builtin_amdgcn_global_load_lds((const unsigned*)((const char*)(gbase) + (voff)[_i]), (PG8_LAS unsigned*)(lds + (bufoff) + ldsw + _i * 8192), 16, 0, 0); } while (0)
#define PG8_LDA(dst, b, h) do { _Pragma("unroll") for (int m = 0; m < 4; ++m) _Pragma("unroll") for (int k = 0; k < 2; ++k) dst[m][k] = *(const PG8_LAS bf16x8*)(lds + PG8_SA(b, h) + aoff + m * 2048 + k * 1024); } while (0)
#define PG8_LDB(dst, b, h) do { _Pragma("unroll") for (int n = 0; n < 2; ++n) _Pragma("unroll") for (int k = 0; k < 2; ++k) dst[n][k] = *(const PG8_LAS bf16x8*)(lds + PG8_SB(b, h) + boff + n * 2048 + k * 1024); } while (0)
#define PG8_MMA(ai, bj, At, Bt) do { __builtin_amdgcn_s_setprio(1); _Pragma("unroll") for (int m = 0; m < 4; ++m) _Pragma("unroll") for (int n = 0; n < 2; ++n) _Pragma("unroll") for (int k = 0; k < 2; ++k) \
        acc[ai][bj][m][n] = __builtin_amdgcn_mfma_f32_16x16x32_bf16(Bt[n][k], At[m][k], acc[ai][bj][m][n], 0, 0, 0); __builtin_amdgcn_s_setprio(0); } while (0)
#define PG8_WAIT_V(n) asm volatile("s_waitcnt vmcnt(" #n ")" ::: "memory")
#define PG8_WAIT_L(n) asm volatile("s_waitcnt lgkmcnt(" #n ")" ::: "memory")
#define PG8_BAR __builtin_amdgcn_s_barrier()
#define PG8_SCHED __builtin_amdgcn_sched_barrier(0)
    Unit cur, nxt; int ui = 0;
    if (!S.next(0, cur)) return;
    f32x4 acc[2][2][4][2];
#pragma unroll
    for (int a = 0; a < 2; ++a)
#pragma unroll
        for (int b = 0; b < 2; ++b)
#pragma unroll
            for (int m = 0; m < 4; ++m)
#pragma unroll
                for (int n = 0; n < 2; ++n) acc[a][b][m][n] = (f32x4){0.f, 0.f, 0.f, 0.f};
    bf16x8 At[4][2], B0[2][2], B1[2][2];
    const char* cA = (const char*)g.A + (size_t)cur.pm * tstep; const char* cB = (const char*)g.Bt + (size_t)cur.pn * tstep;
    S.a_ready(cur);
    if constexpr (SP2) {
        PG8_STAGE(PG8_SB(0, 0), cB, voffB); PG8_STAGE(PG8_SB(0, 1), cB + hstep, voffB); PG8_STAGE(PG8_SA(0, 0), cA, voffA); PG8_STAGE(PG8_SA(0, 1), cA + hstep, voffA);
        if (wr == 1) PG8_BAR;
        PG8_WAIT_V(2); PG8_BAR;
        PG8_STAGE(PG8_SB(1, 0), cB + kstep, voffB); PG8_STAGE(PG8_SA(1, 0), cA + kstep, voffA); PG8_STAGE(PG8_SB(1, 1), cB + hstep + kstep, voffB);
        PG8_WAIT_V(6); PG8_BAR;
    } else {
        PG8_STAGE(PG8_SB(0, 0), cB, voffB); PG8_STAGE(PG8_SA(0, 0), cA, voffA); PG8_STAGE(PG8_SB(0, 1), cB + hstep, voffB); PG8_STAGE(PG8_SA(0, 1), cA + hstep, voffA);
        if (wr == 1) PG8_BAR;
        PG8_WAIT_V(4); PG8_BAR;
        PG8_STAGE(PG8_SB(1, 0), cB + kstep, voffB); PG8_STAGE(PG8_SA(1, 0), cA + kstep, voffA); PG8_STAGE(PG8_SB(1, 1), cB + hstep + kstep, voffB);
        PG8_WAIT_V(6); PG8_BAR;
    }
    for (;;) {
        const bool has_next = S.next(ui + 1, nxt);
        const char* nA = has_next ? (const char*)g.A + (size_t)nxt.pm * tstep : cA; const char* nB = has_next ? (const char*)g.Bt + (size_t)nxt.pn * tstep : cB;
        for (int t = 0; t < nt; t += 2) {
            const bool last = (t == nt - 2);
            const char* a1 = cA + (size_t)(t + 1) * kstep;
            const char* a2 = last ? nA : cA + (size_t)(t + 2) * kstep; const char* b2 = last ? nB : cB + (size_t)(t + 2) * kstep;
            const char* a3 = a2 + kstep; const char* b3 = b2 + kstep;
            if (last && has_next) S.a_ready(nxt);
            if constexpr (SP2) {
            PG8_LDB(B0, 0, 0); PG8_LDB(B1, 0, 1); PG8_SCHED; PG8_LDA(At, 0, 0); PG8_STAGE(PG8_SA(1, 1), a1 + hstep, voffA);
            PG8_WAIT_V(8); PG8_WAIT_L(0); PG8_BAR; PG8_MMA(0, 0, At, B0); PG8_MMA(0, 1, At, B1); PG8_BAR; PG8_SCHED;
            PG8_LDA(At, 0, 1); PG8_STAGE(PG8_SB(0, 0), b2, voffB); PG8_STAGE(PG8_SB(0, 1), b2 + hstep, voffB); PG8_STAGE(PG8_SA(0, 0), a2, voffA);
            PG8_WAIT_V(8); PG8_WAIT_L(0); PG8_BAR; PG8_MMA(1, 0, At, B0); PG8_MMA(1, 1, At, B1); PG8_BAR; PG8_SCHED;
            PG8_LDB(B0, 1, 0); PG8_LDB(B1, 1, 1); PG8_SCHED; PG8_LDA(At, 1, 0); PG8_STAGE(PG8_SA(0, 1), a2 + hstep, voffA);
            PG8_WAIT_V(8); PG8_WAIT_L(0); PG8_BAR; PG8_MMA(0, 0, At, B0); PG8_MMA(0, 1, At, B1); PG8_BAR; PG8_SCHED;
            PG8_LDA(At, 1, 1); PG8_STAGE(PG8_SB(1, 0), b3, voffB); PG8_STAGE(PG8_SB(1, 1), b3 + hstep, voffB); PG8_STAGE(PG8_SA(1, 0), a3, voffA);
            PG8_WAIT_V(8); PG8_WAIT_L(0); PG8_BAR; PG8_MMA(1, 0, At, B0); PG8_MMA(1, 1, At, B1); PG8_BAR; PG8_SCHED;
            } else {
            PG8_LDB(B0, 0, 0); PG8_SCHED; PG8_LDA(At, 0, 0); PG8_STAGE(PG8_SA(1, 1), a1 + hstep, voffA);
            PG8_WAIT_L(8); PG8_BAR; PG8_WAIT_L(0); PG8_MMA(0, 0, At, B0); PG8_BAR; PG8_SCHED;
            PG8_LDB(B1, 0, 1); PG8_STAGE(PG8_SB(0, 0), b2, voffB);
            PG8_BAR; PG8_WAIT_L(0); PG8_MMA(0, 1, At, B1); PG8_BAR;
            PG8_LDA(At, 0, 1); PG8_STAGE(PG8_SA(0, 0), a2, voffA);
            PG8_BAR; PG8_WAIT_L(0); PG8_MMA(1, 0, At, B0); PG8_BAR; PG8_SCHED;
            PG8_STAGE(PG8_SB(0, 1), b2 + hstep, voffB);
            PG8_WAIT_V(6); PG8_BAR; PG8_MMA(1, 1, At, B1); PG8_BAR;
            PG8_LDB(B0, 1, 0); PG8_SCHED; PG8_LDA(At, 1, 0); PG8_STAGE(PG8_SA(0, 1), a2 + hstep, voffA);
            PG8_WAIT_L(8); PG8_BAR; PG8_WAIT_L(0); PG8_MMA(0, 0, At, B0); PG8_BAR; PG8_SCHED;
            PG8_LDB(B1, 1, 1); PG8_STAGE(PG8_SB(1, 0), b3, voffB);
            PG8_BAR; PG8_WAIT_L(0); PG8_MMA(0, 1, At, B1); PG8_BAR;
            PG8_LDA(At, 1, 1); PG8_STAGE(PG8_SA(1, 0), a3, voffA);
            PG8_BAR; PG8_WAIT_L(0); PG8_MMA(1, 0, At, B0); PG8_BAR; PG8_SCHED;
            PG8_STAGE(PG8_SB(1, 1), b3 + hstep, voffB);
            PG8_WAIT_V(6); PG8_BAR; PG8_MMA(1, 1, At, B1); PG8_BAR;
            }
        }
        if constexpr (ALIGN_EPI) { if (wr == 0) PG8_BAR; }
        if constexpr (!Epi::AFTER_DRAIN) { E(acc, cur, wr, wc, fr, fq); S.done(cur); }
        if (!has_next) break;
#pragma unroll
        for (int a = 0; a < 2; ++a)
#pragma unroll
            for (int b = 0; b < 2; ++b)
#pragma unroll
                for (int m = 0; m < 4; ++m)
#pragma unroll
                    for (int n = 0; n < 2; ++n) acc[a][b][m][n] = (f32x4){0.f, 0.f, 0.f, 0.f};
        cur = nxt; cA = nA; cB = nB; ++ui;
        if constexpr (ALIGN_EPI) { if (wr == 1) PG8_BAR; }
    }
    PG8_WAIT_V(0);
    if constexpr (!ALIGN_EPI) { if (wr == 0) PG8_BAR; }
    PG8_BAR;
    if constexpr (Epi::AFTER_DRAIN) { E.fused(acc, cur, wr, wc, fr, fq, lds, wid, lane); S.done(cur); }
#undef PG8_SA
#undef PG8_SB
#undef PG8_STAGE
#undef PG8_LDA
#undef PG8_LDB
#undef PG8_MMA
#undef PG8_WAIT_V
#undef PG8_WAIT_L
#undef PG8_BAR
#undef PG8_SCHED
}
}

#ifndef MK_N_LAUNCHES
#define MK_N_LAUNCHES 1
#endif
constexpr int BATCH = 2, SEQ = 8192, D = 1024, M = BATCH * SEQ, INC = 3072, FF = 4096;
constexpr int NPH = 14;
constexpr float EPS = 1e-6f;
constexpr float LOG2E = 1.4426950408889634f;
constexpr size_t MiB = 1u << 20;
constexpr size_t WS_CTL = 0, CTL_ZERO_BYTES = 393216;
constexpr int MISC_OFF = 147392;
constexpr size_t WS_WIN = 1 * MiB, WS_WOUT = 7 * MiB, WS_WXQ = 9 * MiB, WS_WXKV = 11 * MiB, WS_WXO = 15 * MiB, WS_WFF1 = 17 * MiB, WS_WFF2 = 25 * MiB;
constexpr size_t WS_MEMN = 33 * MiB, WS_KX = 34 * MiB, WS_VTX = 35 * MiB;
constexpr size_t WS_H = 40 * MiB;
constexpr size_t WS_MIX = 72 * MiB;
constexpr size_t WS_QO = 104 * MiB;
constexpr size_t WS_PROJ = 136 * MiB;
constexpr size_t WS_F = 104 * MiB;
constexpr size_t WS_END = 232 * MiB;
constexpr int LDS_BYTES = 147456;

#define LAS __attribute__((address_space(3)))
typedef unsigned short bf16;
typedef float f32x4 __attribute__((ext_vector_type(4)));
typedef short bf16x8 __attribute__((ext_vector_type(8)));
typedef unsigned u32x4 __attribute__((ext_vector_type(4)));
typedef unsigned u32x2 __attribute__((ext_vector_type(2)));
#define LDS_WAIT() asm volatile("s_waitcnt lgkmcnt(0)" ::: "memory")

__device__ __forceinline__ unsigned pk2(float lo, float hi) { return pg8::cvt_pk_bf16(lo, hi); }
__device__ __forceinline__ float bflo(unsigned w) { return __uint_as_float(w << 16); }
__device__ __forceinline__ float bfhi(unsigned w) { return __uint_as_float(w & 0xffff0000u); }
__device__ __forceinline__ float bfe(const u32x4& w, int e) { const unsigned x = w[e >> 1]; return (e & 1) ? bfhi(x) : bflo(x); }
struct WsRef { __amdgpu_buffer_rsrc_t r; const unsigned char* base; };
__device__ __forceinline__ u32x4 ws_load16(const WsRef& w, unsigned byte_off) { return __builtin_bit_cast(u32x4, __builtin_amdgcn_raw_buffer_load_b128(w.r, byte_off, 0, 0)); }
__device__ __forceinline__ void wt_store8(const WsRef& w, const void* p, u32x2 v) { __builtin_amdgcn_raw_buffer_store_b64(v, w.r, (unsigned)((const unsigned char*)p - w.base), 0, 16); }
__device__ __forceinline__ void wt_store16(const WsRef& w, const void* p, u32x4 v) { __builtin_amdgcn_raw_buffer_store_b128(v, w.r, (unsigned)((const unsigned char*)p - w.base), 0, 16); }
__device__ __forceinline__ float wave_sum(float v) {
#pragma unroll
    for (int o = 1; o < 64; o <<= 1) v += __shfl_xor(v, o);
    return v;
}
__device__ __forceinline__ void fast_sincos(float ang, float& s, float& c) {
    const float k = rintf(ang * 0.15915494309189535f);
    float r = fmaf(-k, 6.28125f, ang);
    r = fmaf(-k, 0.0019353071795864769f, r);
    s = __sinf(r); c = __cosf(r);
}
__device__ __forceinline__ float fexp2(float x) { return __builtin_amdgcn_exp2f(x); }
__device__ __forceinline__ float log_sigmoid(float x) { return -log1pf(expf(-x)); }

__device__ __forceinline__ void p0_transpose_item(const float* W, int K, int N, bf16* WT, LAS float* scr, int item, int lane, const float* kscale = nullptr) {
    const int nblk = N / 32, kb = item / nblk, nb = item % nblk, k0 = 64 * kb, n0 = 32 * nb;
#pragma unroll 8
    for (int i = 0; i < 32; ++i) { const int kk = 2 * i + (lane >> 5); scr[kk * 33 + (lane & 31)] = W[(size_t)(k0 + kk) * N + n0 + (lane & 31)] * (kscale ? kscale[k0 + kk] : 1.0f); }
    LDS_WAIT(); asm volatile("" ::: "memory");
    const int c = lane & 7;
#pragma unroll
    for (int j = 0; j < 4; ++j) { const int n = (lane >> 3) + 8 * j; const LAS float* s = scr + (8 * c) * 33 + n;
        u32x4 o; o.x = pk2(s[0 * 33], s[1 * 33]); o.y = pk2(s[2 * 33], s[3 * 33]); o.z = pk2(s[4 * 33], s[5 * 33]); o.w = pk2(s[6 * 33], s[7 * 33]);
        *(u32x4*)(WT + (size_t)(n0 + n) * K + k0 + 8 * c) = o; }
    LDS_WAIT(); asm volatile("" ::: "memory");
}
__device__ __forceinline__ void p0_transpose_item64(const WsRef& wsr, const float* W, int K, int N, bf16* WT, LAS float* scr, int item, int lane, const float* kscale = nullptr) {
    const int nblk = N / 64, kb = item / nblk, nb = item % nblk, k0 = 64 * kb, n0 = 64 * nb;
    const int kq = lane >> 4, nq = lane & 15;
    f32x4 v[16];
#pragma unroll
    for (int i = 0; i < 16; ++i) v[i] = *(const f32x4*)(W + (size_t)(k0 + 4 * i + kq) * N + n0 + nq * 4);
#pragma unroll
    for (int i = 0; i < 16; ++i) { const int kk = 4 * i + kq; const float sc = kscale ? kscale[k0 + kk] : 1.0f; LAS float* d = scr + kk * 65 + nq * 4;
        d[0] = v[i][0] * sc; d[1] = v[i][1] * sc; d[2] = v[i][2] * sc; d[3] = v[i][3] * sc; }
    LDS_WAIT(); asm volatile("" ::: "memory");
    const int c = lane & 7;
#pragma unroll
    for (int j = 0; j < 8; ++j) { const int n = (lane >> 3) + 8 * j; const LAS float* s = scr + (8 * c) * 65 + n;
        u32x4 o; o.x = pk2(s[0 * 65], s[1 * 65]); o.y = pk2(s[2 * 65], s[3 * 65]); o.z = pk2(s[4 * 65], s[5 * 65]); o.w = pk2(s[6 * 65], s[7 * 65]);
        wt_store16(wsr, WT + (size_t)(n0 + n) * K + k0 + 8 * c, o); }
    LDS_WAIT(); asm volatile("" ::: "memory");
}
__device__ __forceinline__ void rms_row_to_bf16(const float* xrow, const float* w, bf16* orow, int lane) {
    const f32x4* xr = (const f32x4*)xrow + lane; const f32x4* wr = (const f32x4*)w + lane;
    f32x4 v[4]; float s = 0.f;
#pragma unroll
    for (int j = 0; j < 4; ++j) { v[j] = xr[64 * j]; s += (v[j].x * v[j].x + v[j].y * v[j].y) + (v[j].z * v[j].z + v[j].w * v[j].w); }
    const float rstd = rsqrtf(wave_sum(s) * (1.f / D) + EPS);
    u32x2* o8 = (u32x2*)orow + lane;
#pragma unroll
    for (int j = 0; j < 4; ++j) { const f32x4 ww = wr[64 * j]; u32x2 o; o.x = pk2(v[j].x * rstd * ww.x, v[j].y * rstd * ww.y); o.y = pk2(v[j].z * rstd * ww.z, v[j].w * rstd * ww.w); o8[64 * j] = o; }
}
__device__ __forceinline__ void rms_row_to_f32(const float* xrow, const float* w, float* orow, int lane) {
    const f32x4* xr = (const f32x4*)xrow + lane; const f32x4* wr = (const f32x4*)w + lane;
    f32x4 v[4]; float s = 0.f;
#pragma unroll
    for (int j = 0; j < 4; ++j) { v[j] = xr[64 * j]; s += (v[j].x * v[j].x + v[j].y * v[j].y) + (v[j].z * v[j].z + v[j].w * v[j].w); }
    const float rstd = rsqrtf(wave_sum(s) * (1.f / D) + EPS);
    f32x4* o = (f32x4*)orow + lane;
#pragma unroll
    for (int j = 0; j < 4; ++j) { const f32x4 ww = wr[64 * j]; o[64 * j] = v[j] * rstd * ww; }
}

constexpr int LDT = 136;
constexpr int TILE_B = 128 * LDT * 2;
#define MFMA16(a, b, c) __builtin_amdgcn_mfma_f32_16x16x32_bf16((a), (b), (c), 0, 0, 0)

struct UnitRaw { u32x4 a1[2], a2[2], k1[2], k2[2], v[4]; float p[2]; };
template <bool WITHQ> __device__ __forceinline__ void raw_load(UnitRaw& r, int u, const bf16* PROJ, const int* pos, int tid) {
    const int bh = u >> 6, c = u & 63, b = bh >> 2, h = bh & 3; const size_t row0 = (size_t)b * SEQ + (size_t)c * 128;
#pragma unroll
    for (int i = 0; i < 2; ++i) { const int it = tid + 512 * i, dc = it & 7, j = it >> 3; const bf16* qr = PROJ + (row0 + j) * INC + h * 128 + dc * 8; const bf16* kr = qr + 512;
        if (WITHQ) { r.a1[i] = *(const u32x4*)qr; r.a2[i] = *(const u32x4*)(qr + 64); }
        r.k1[i] = *(const u32x4*)kr; r.k2[i] = *(const u32x4*)(kr + 64); r.p[i] = (float)pos[row0 + j]; }
#pragma unroll
    for (int i = 0; i < 4; ++i) { const int it = tid + 512 * i, ec = it & 15, j = it >> 4; r.v[i] = *(const u32x4*)(PROJ + (row0 + j) * INC + 1024 + h * 128 + ec * 8); }
}
__device__ __forceinline__ void stage_vt_regs(LAS bf16* VT, const UnitRaw& r, int tid) {
#pragma unroll
    for (int i = 0; i < 4; ++i) { const int it = tid + 512 * i, ec = it & 15, j = it >> 4; const u32x4 w = r.v[i];
        const int jsw = (((j >> 3) ^ (ec & 7)) << 3) | (j & 7);
#pragma unroll
        for (int e = 0; e < 4; ++e) { VT[(ec * 8 + 2 * e) * LDT + jsw] = (bf16)(w[e] & 0xffffu); VT[(ec * 8 + 2 * e + 1) * LDT + jsw] = (bf16)(w[e] >> 16); } }
}
__device__ __forceinline__ void stage_vt(LAS bf16* VT, const bf16* PROJ, size_t row0, int h, int tid) {
    for (int it = tid; it < 2048; it += 512) { const int ec = it & 15, j = it >> 4;
        const u32x4 w = *(const u32x4*)(PROJ + (row0 + j) * INC + 1024 + h * 128 + ec * 8);
        const int jsw = (((j >> 3) ^ (ec & 7)) << 3) | (j & 7);
#pragma unroll
        for (int e = 0; e < 4; ++e) { VT[(ec * 8 + 2 * e) * LDT + jsw] = (bf16)(w[e] & 0xffffu); VT[(ec * 8 + 2 * e + 1) * LDT + jsw] = (bf16)(w[e] >> 16); } }
}

__device__ __forceinline__ void kv_unit(LAS unsigned char* lds, int u, const bf16* PROJ, const int* pos, const float* dec_f, const float* dec_b, bf16* KVc, int tid, UnitRaw& raw, int next_u) {
    const int lane = tid & 63, wave = tid >> 6, fr = lane & 15, fq = lane >> 4;
    const int bh = u >> 6, c = u & 63, h = bh & 3;
    LAS bf16* KTf = (LAS bf16*)lds; LAS bf16* KTb = (LAS bf16*)(lds + TILE_B); LAS bf16* VT = (LAS bf16*)(lds + 2 * TILE_B);
    const float lgf2 = log_sigmoid(dec_f[h]) * LOG2E, lgb2 = log_sigmoid(dec_b[h]) * LOG2E;
#pragma unroll
    for (int ii = 0; ii < 2; ++ii) { const int it = tid + 512 * ii, dc = it & 7, j = it >> 3;
        const u32x4 w1 = raw.k1[ii], w2 = raw.k2[ii];
        const float p = raw.p[ii];
        const float zf = fexp2(lgf2 * (float)(127 - j)) * 0.08838834764831845f, zb = fexp2(lgb2 * (float)j) * 0.08838834764831845f;
        const int jsw = (((j >> 3) ^ (dc & 7)) << 3) | (j & 7);
#pragma unroll
        for (int e = 0; e < 8; ++e) { const int i = dc * 8 + e; const float inv = fexp2(-(float)i * 0.20762050593046015f);
            float sn, cs; fast_sincos(p * inv, sn, cs);
            const float k1 = bfe(w1, e), k2 = bfe(w2, e), r1 = k1 * cs - k2 * sn, r2 = k2 * cs + k1 * sn;
            const unsigned pf = pk2(r1 * zf, r2 * zf), pb = pk2(r1 * zb, r2 * zb);
            KTf[i * LDT + jsw] = (bf16)(pf & 0xffffu); KTf[(i + 64) * LDT + jsw] = (bf16)(pf >> 16);
            KTb[i * LDT + jsw] = (bf16)(pb & 0xffffu); KTb[(i + 64) * LDT + jsw] = (bf16)(pb >> 16); }
        __builtin_amdgcn_sched_barrier(0); }
    stage_vt_regs(VT, raw, tid);
    __syncthreads();
    if (next_u >= 0) raw_load<false>(raw, next_u, PROJ, pos, tid);
    f32x4 accf[8], accb[8];
#pragma unroll
    for (int n = 0; n < 8; ++n) { accf[n] = (f32x4){0.f, 0.f, 0.f, 0.f}; accb[n] = (f32x4){0.f, 0.f, 0.f, 0.f}; }
#pragma unroll
    for (int kk = 0; kk < 4; ++kk) { const bf16x8 xf = *(const LAS bf16x8*)(VT + (wave * 16 + fr) * LDT + (((kk * 4 + fq) ^ ((2 * wave + (fr >> 3)) & 7)) << 3));
#pragma unroll
        for (int n = 0; n < 8; ++n) { const int co = (((kk * 4 + fq) ^ ((2 * n + (fr >> 3)) & 7)) << 3); const bf16x8 yf = *(const LAS bf16x8*)(KTf + (n * 16 + fr) * LDT + co); const bf16x8 yb = *(const LAS bf16x8*)(KTb + (n * 16 + fr) * LDT + co);
            accf[n] = MFMA16(yf, xf, accf[n]); accb[n] = MFMA16(yb, xf, accb[n]); } }
    bf16* of = KVc + ((size_t)bh * 64 + c) * 16384 + (wave * 16 + fr) * 128 + 4 * fq;
    bf16* ob = of + (size_t)8 * 64 * 16384;
#pragma unroll
    for (int n = 0; n < 8; ++n) { u32x2 w; w.x = pk2(accf[n][0], accf[n][1]); w.y = pk2(accf[n][2], accf[n][3]); *(u32x2*)(of + n * 16) = w;
        u32x2 v; v.x = pk2(accb[n][0], accb[n][1]); v.y = pk2(accb[n][2], accb[n][3]); *(u32x2*)(ob + n * 16) = v; }
    __syncthreads();
}

__device__ __forceinline__ void ret_unit(LAS unsigned char* lds, int u, const bf16* PROJ, const int* pos, const float* dec_f, const float* dec_b, const bf16* ST,
                                         const float* gn_w, const float* gn_b, bf16* MIX, int tid, const WsRef& wsr) {
    const int lane = tid & 63, wave = tid >> 6, fr = lane & 15, fq = lane >> 4;
    const int bh = u >> 6, c = u & 63, b = bh >> 2, h = bh & 3;
    const size_t row0 = (size_t)b * SEQ + (size_t)c * 128;
    LAS bf16* Qs = (LAS bf16*)lds; LAS bf16* Ks = (LAS bf16*)(lds + TILE_B); LAS bf16* VT = (LAS bf16*)(lds + 2 * TILE_B);
    const float lgf2 = log_sigmoid(dec_f[h]) * LOG2E, lgb2 = log_sigmoid(dec_b[h]) * LOG2E;
    const u32x4* sfp = (const u32x4*)(ST + ((size_t)bh * 64 + c) * 16384); const u32x4* sbp = (const u32x4*)(ST + ((size_t)(8 + bh) * 64 + c) * 16384);
    u32x4 sf[4], sb[4];
#pragma unroll
    for (int i = 0; i < 4; ++i) { sf[i] = sfp[tid + 512 * i]; sb[i] = sbp[tid + 512 * i]; }
    u32x4 rq1[2], rq2[2], rk1[2], rk2[2], rv[4]; float rp[2];
#pragma unroll
    for (int ii = 0; ii < 2; ++ii) { const int it = tid + 512 * ii, dc = it & 7, j = it >> 3; const unsigned qo = (unsigned)WS_PROJ + (unsigned)(((unsigned)(row0 + j) * INC + h * 128 + dc * 8) * 2u);
        rq1[ii] = ws_load16(wsr, qo); rq2[ii] = ws_load16(wsr, qo + 128u); rk1[ii] = ws_load16(wsr, qo + 1024u); rk2[ii] = ws_load16(wsr, qo + 1152u); rp[ii] = (float)pos[row0 + j]; }
#pragma unroll
    for (int ii = 0; ii < 2; ++ii) { const int it = tid + 512 * ii, dc = it & 7, j = it >> 3;
        const u32x4 q1 = rq1[ii], q2 = rq2[ii], k1 = rk1[ii], k2 = rk2[ii];
        const float p = rp[ii];
        float sn[8], cs[8];
#pragma unroll
        for (int e = 0; e < 8; ++e) { const int i = dc * 8 + e; const float inv = fexp2(-(float)i * 0.20762050593046015f); fast_sincos(p * inv, sn[e], cs[e]); }
        u32x4 oq1, oq2, ok1, ok2;
#pragma unroll
        for (int e = 0; e < 4; ++e) { const int e0 = 2 * e, e1 = 2 * e + 1;
            const float a0 = bflo(q1[e]), a1 = bfhi(q1[e]), b0 = bflo(q2[e]), b1 = bfhi(q2[e]);
            oq1[e] = pk2(a0 * cs[e0] - b0 * sn[e0], a1 * cs[e1] - b1 * sn[e1]); oq2[e] = pk2(b0 * cs[e0] + a0 * sn[e0], b1 * cs[e1] + a1 * sn[e1]);
            const float c0 = bflo(k1[e]) * 0.08838834764831845f, c1 = bfhi(k1[e]) * 0.08838834764831845f, d0 = bflo(k2[e]) * 0.08838834764831845f, d1 = bfhi(k2[e]) * 0.08838834764831845f;
            ok1[e] = pk2(c0 * cs[e0] - d0 * sn[e0], c1 * cs[e1] - d1 * sn[e1]); ok2[e] = pk2(d0 * cs[e0] + c0 * sn[e0], d1 * cs[e1] + c1 * sn[e1]); }
        *(LAS u32x4*)(Qs + j * LDT + dc * 8) = oq1; *(LAS u32x4*)(Qs + j * LDT + 64 + dc * 8) = oq2;
        *(LAS u32x4*)(Ks + j * LDT + dc * 8) = ok1; *(LAS u32x4*)(Ks + j * LDT + 64 + dc * 8) = ok2; }
#pragma unroll
    for (int ii = 0; ii < 4; ++ii) { const int it = tid + 512 * ii, ec = it & 15, j = it >> 4; rv[ii] = ws_load16(wsr, (unsigned)WS_PROJ + (unsigned)(((unsigned)(row0 + j) * INC + 1024 + h * 128 + ec * 8) * 2u)); }
#pragma unroll
    for (int ii = 0; ii < 4; ++ii) { const int it = tid + 512 * ii, ec = it & 15, j = it >> 4; const u32x4 w = rv[ii];
        const int jsw = (((j >> 3) ^ (ec & 7)) << 3) | (j & 7);
#pragma unroll
        for (int e = 0; e < 4; ++e) { VT[(ec * 8 + 2 * e) * LDT + jsw] = (bf16)(w[e] & 0xffffu); VT[(ec * 8 + 2 * e + 1) * LDT + jsw] = (bf16)(w[e] >> 16); } }
    __syncthreads();
    const int q = wave * 16 + fr;
    bf16x8 qf[4];
#pragma unroll
    for (int kk = 0; kk < 4; ++kk) qf[kk] = *(const LAS bf16x8*)(Qs + q * LDT + kk * 32 + fq * 8);
    f32x4 s[8];
#pragma unroll
    for (int n = 0; n < 8; ++n) s[n] = (f32x4){0.f, 0.f, 0.f, 0.f};
#pragma unroll
    for (int kk = 0; kk < 4; ++kk)
#pragma unroll
        for (int n = 0; n < 8; ++n) { const bf16x8 kf = *(const LAS bf16x8*)(Ks + (n * 16 + fr) * LDT + kk * 32 + fq * 8); s[n] = MFMA16(kf, qf[kk], s[n]); }
    bf16x8 pf[4];
#pragma unroll
    for (int n = 0; n < 8; ++n) {
#pragma unroll
        for (int r = 0; r < 4; ++r) { const int key = n * 16 + 4 * fq + r; const int df = q - key; const float f = df >= 0 ? fexp2(lgf2 * (float)df) : fexp2(lgb2 * (float)(-df)); s[n][r] *= f; } }
#pragma unroll
    for (int kk = 0; kk < 4; ++kk) { u32x4 w; w.x = pk2(s[2 * kk][0], s[2 * kk][1]); w.y = pk2(s[2 * kk][2], s[2 * kk][3]); w.z = pk2(s[2 * kk + 1][0], s[2 * kk + 1][1]); w.w = pk2(s[2 * kk + 1][2], s[2 * kk + 1][3]);
        pf[kk] = __builtin_bit_cast(bf16x8, w); }
    f32x4 o[8];
#pragma unroll
    for (int n = 0; n < 8; ++n) o[n] = (f32x4){0.f, 0.f, 0.f, 0.f};
#pragma unroll
    for (int kk = 0; kk < 4; ++kk)
#pragma unroll
        for (int n = 0; n < 8; ++n) { const int sw = (2 * n + (fr >> 3)) & 7, jc = kk * 4 + (fq >> 1); const LAS bf16* vr = VT + (n * 16 + fr) * LDT + 4 * (fq & 1);
            const u32x2 lo = *(const LAS u32x2*)(vr + ((jc ^ sw) << 3)), hi = *(const LAS u32x2*)(vr + (((jc + 2) ^ sw) << 3)); u32x4 w; w.x = lo.x; w.y = lo.y; w.z = hi.x; w.w = hi.y;
            o[n] = MFMA16(__builtin_bit_cast(bf16x8, w), pf[kk], o[n]); }
    __syncthreads();
#pragma unroll
    for (int i = 0; i < 4; ++i) { const int id = tid + 512 * i, e = id >> 4, dch = id & 15;
        *(LAS u32x4*)(Ks + e * LDT + dch * 8) = sf[i]; *(LAS u32x4*)(VT + e * LDT + dch * 8) = sb[i]; }
    __syncthreads();
    {
        f32x4 tf[8], tb[8];
#pragma unroll
        for (int n = 0; n < 8; ++n) { tf[n] = (f32x4){0.f, 0.f, 0.f, 0.f}; tb[n] = (f32x4){0.f, 0.f, 0.f, 0.f}; }
#pragma unroll
        for (int kk = 0; kk < 4; ++kk)
#pragma unroll
            for (int n = 0; n < 8; ++n) { const bf16x8 yf = *(const LAS bf16x8*)(Ks + (n * 16 + fr) * LDT + kk * 32 + fq * 8); const bf16x8 yb = *(const LAS bf16x8*)(VT + (n * 16 + fr) * LDT + kk * 32 + fq * 8);
                tf[n] = MFMA16(yf, qf[kk], tf[n]); tb[n] = MFMA16(yb, qf[kk], tb[n]); }
        const float xif = fexp2(lgf2 * (float)(q + 1)), xib = fexp2(lgb2 * (float)(128 - q));
#pragma unroll
        for (int n = 0; n < 8; ++n) o[n] = o[n] + tf[n] * xif + tb[n] * xib;
    }
    float sm = 0.f;
#pragma unroll
    for (int n = 0; n < 8; ++n) sm += (o[n][0] + o[n][1]) + (o[n][2] + o[n][3]);
    sm += __shfl_xor(sm, 16); sm += __shfl_xor(sm, 32);
    const float mu = sm * (1.f / 128.f);
    float vq = 0.f;
#pragma unroll
    for (int n = 0; n < 8; ++n) { const f32x4 d = o[n] - mu; vq += (d[0] * d[0] + d[1] * d[1]) + (d[2] * d[2] + d[3] * d[3]); }
    vq += __shfl_xor(vq, 16); vq += __shfl_xor(vq, 32);
    const float rstd = rsqrtf(vq * (1.f / 128.f) + EPS);
    const size_t row = row0 + q;
#pragma unroll
    for (int n = 0; n < 8; ++n) { const int col = h * 128 + n * 16 + 4 * fq;
        const f32x4 gw = *(const f32x4*)(gn_w + col), gb = *(const f32x4*)(gn_b + col);
        const u32x2 gg = *(const u32x2*)(PROJ + row * INC + 1536 + col);
        const f32x4 g = (f32x4){bflo(gg.x), bfhi(gg.x), bflo(gg.y), bfhi(gg.y)};
        f32x4 y = (o[n] - mu) * rstd * gw + gb;
#pragma unroll
        for (int r = 0; r < 4; ++r) y[r] = y[r] * g[r] * __builtin_amdgcn_rcpf(1.f + __expf(-g[r]));
        u32x2 w; w.x = pk2(y[0], y[1]); w.y = pk2(y[2], y[3]); *(u32x2*)(MIX + row * D + col) = w; }
    __syncthreads();
}

__device__ __forceinline__ void conv_unit(LAS unsigned char* lds, int u, const bf16* PROJ, const float* conv_w, const float* conv_b, const float* ln_w, const float* ln_b, bf16* MIX, int tid, const WsRef& wsr) {
    const int lane = tid & 63, wave = tid >> 6;
    LAS float* U = (LAS float*)lds;
    const int t0 = (u * 32) % SEQ; const size_t rowb = (size_t)(u * 32 / SEQ) * SEQ;
    for (int it = tid; it < 62 * 64; it += 512) { const int r = it >> 6, cc = it & 63; const int t = t0 - 15 + r;
        f32x4 u0 = (f32x4){0.f, 0.f, 0.f, 0.f}, u1 = u0;
        if (t >= 0 && t < SEQ) { const bf16* pr = PROJ + (rowb + t) * INC + 2048 + cc * 8; const u32x4 a = *(const u32x4*)pr, g = *(const u32x4*)(pr + 512);
#pragma unroll
            for (int e = 0; e < 4; ++e) { const float a0 = bflo(a[e]), a1 = bfhi(a[e]), g0 = bflo(g[e]), g1 = bfhi(g[e]);
                const float v0 = a0 * __builtin_amdgcn_rcpf(1.f + __expf(-g0)), v1 = a1 * __builtin_amdgcn_rcpf(1.f + __expf(-g1));
                if (e < 2) { u0[2 * e] = v0; u0[2 * e + 1] = v1; } else { u1[2 * e - 4] = v0; u1[2 * e - 3] = v1; } } }
        *(LAS f32x4*)(U + r * 512 + cc * 8) = u0; *(LAS f32x4*)(U + r * 512 + cc * 8 + 4) = u1; }
    float w[31];
#pragma unroll
    for (int k = 0; k < 31; ++k) w[k] = conv_w[k * 512 + tid];
    const float bias = conv_b[tid];
    __syncthreads();
    for (int tb = 0; tb < 4; ++tb) {
        float uw[38];
#pragma unroll
        for (int r = 0; r < 38; ++r) uw[r] = U[(tb * 8 + r) * 512 + tid];
        typedef float f2v __attribute__((ext_vector_type(2)));
        f2v y2[4];
#pragma unroll
        for (int t = 0; t < 4; ++t) y2[t] = (f2v){bias, bias};
#pragma unroll
        for (int k = 0; k < 31; ++k) { const f2v wk = (f2v){w[k], w[k]};
#pragma unroll
            for (int t = 0; t < 4; ++t) y2[t] = __builtin_elementwise_fma(wk, (f2v){uw[2 * t + k], uw[2 * t + k + 1]}, y2[t]); }
#pragma unroll
        for (int t = 0; t < 4; ++t) { U[(tb * 8 + 2 * t) * 512 + tid] = y2[t].x; U[(tb * 8 + 2 * t + 1) * 512 + tid] = y2[t].y; }
    }
    __syncthreads();
#pragma unroll
    for (int i = 0; i < 4; ++i) { const int tt = wave * 4 + i;
        const f32x4 a = *(const LAS f32x4*)(U + tt * 512 + lane * 8), b = *(const LAS f32x4*)(U + tt * 512 + lane * 8 + 4);
        const float mu = wave_sum((a[0] + a[1]) + (a[2] + a[3]) + (b[0] + b[1]) + (b[2] + b[3])) * (1.f / 512.f);
        const f32x4 da = a - mu, db = b - mu;
        const float var = wave_sum((da[0] * da[0] + da[1] * da[1]) + (da[2] * da[2] + da[3] * da[3]) + (db[0] * db[0] + db[1] * db[1]) + (db[2] * db[2] + db[3] * db[3])) * (1.f / 512.f);
        const float rstd = rsqrtf(var + EPS);
        const f32x4 wa = *(const f32x4*)(ln_w + lane * 8), wb = *(const f32x4*)(ln_w + lane * 8 + 4), ba = *(const f32x4*)(ln_b + lane * 8), bb = *(const f32x4*)(ln_b + lane * 8 + 4);
        f32x4 ya = da * rstd * wa + ba, yb = db * rstd * wb + bb;
#pragma unroll
        for (int e = 0; e < 4; ++e) { ya[e] = ya[e] * __builtin_amdgcn_rcpf(1.f + __expf(-ya[e])); yb[e] = yb[e] * __builtin_amdgcn_rcpf(1.f + __expf(-yb[e])); }
        u32x4 o; o.x = pk2(ya[0], ya[1]); o.y = pk2(ya[2], ya[3]); o.z = pk2(yb[0], yb[1]); o.w = pk2(yb[2], yb[3]);
        wt_store16(wsr, MIX + (rowb + t0 + tt) * D + 512 + lane * 8, o); }
    __syncthreads();
}

constexpr int LDX = 264;
__device__ __forceinline__ void xattn_unit(LAS unsigned char* lds, int u, const bf16* QO, bf16* OB, const bf16* Kx, const bf16* VTx, int tid) {
    const int lane = tid & 63, wave = tid >> 6, fr = lane & 15, fq = lane >> 4;
    const int bh = u >> 6, qt = u & 63, b = bh >> 2, h = bh & 3;
    LAS bf16* T = (LAS bf16*)lds;
    const size_t row = (size_t)b * SEQ + (size_t)qt * 128 + wave * 16 + fr;
    const bf16* qp = QO + row * D + h * 256; bf16* op = OB + row * D + h * 256;
    bf16x8 qf[8];
#pragma unroll
    for (int kk = 0; kk < 8; ++kk) qf[kk] = *(const bf16x8*)(qp + kk * 32 + fq * 8);
    const u32x4* kg = (const u32x4*)(Kx + (size_t)bh * 65536);
#pragma unroll 4
    for (int i = 0; i < 16; ++i) { const int id = tid + 512 * i, r = id >> 5, ch = id & 31; *(LAS u32x4*)(T + r * LDX + ch * 8) = kg[id]; }
    __syncthreads();
    f32x4 s[16];
#pragma unroll
    for (int n = 0; n < 16; ++n) s[n] = (f32x4){0.f, 0.f, 0.f, 0.f};
#pragma unroll
    for (int kk = 0; kk < 8; ++kk)
#pragma unroll
        for (int n = 0; n < 16; ++n) { const bf16x8 kf = *(const LAS bf16x8*)(T + (n * 16 + fr) * LDX + kk * 32 + fq * 8); s[n] = MFMA16(kf, qf[kk], s[n]); }
    float mx = -3.0e38f;
#pragma unroll
    for (int n = 0; n < 16; ++n) mx = fmaxf(mx, fmaxf(fmaxf(s[n][0], s[n][1]), fmaxf(s[n][2], s[n][3])));
    mx = fmaxf(mx, __shfl_xor(mx, 16)); mx = fmaxf(mx, __shfl_xor(mx, 32));
    const float sc = 0.0625f * LOG2E; float sum = 0.f;
#pragma unroll
    for (int n = 0; n < 16; ++n)
#pragma unroll
        for (int r = 0; r < 4; ++r) { const float p = fexp2((s[n][r] - mx) * sc); s[n][r] = p; sum += p; }
    sum += __shfl_xor(sum, 16); sum += __shfl_xor(sum, 32);
    const float rinv = 1.f / sum;
    bf16x8 pf[8];
#pragma unroll
    for (int kk = 0; kk < 8; ++kk) { u32x4 w; w.x = pk2(s[2 * kk][0], s[2 * kk][1]); w.y = pk2(s[2 * kk][2], s[2 * kk][3]); w.z = pk2(s[2 * kk + 1][0], s[2 * kk + 1][1]); w.w = pk2(s[2 * kk + 1][2], s[2 * kk + 1][3]);
        pf[kk] = __builtin_bit_cast(bf16x8, w); }
    __syncthreads();
    const u32x4* vg = (const u32x4*)(VTx + (size_t)bh * 65536);
#pragma unroll 4
    for (int i = 0; i < 16; ++i) { const int id = tid + 512 * i, r = id >> 5, ch = id & 31; *(LAS u32x4*)(T + r * LDX + ch * 8) = vg[id]; }
    __syncthreads();
    f32x4 o[16];
#pragma unroll
    for (int n = 0; n < 16; ++n) o[n] = (f32x4){0.f, 0.f, 0.f, 0.f};
#pragma unroll
    for (int kk = 0; kk < 8; ++kk)
#pragma unroll
        for (int n = 0; n < 16; ++n) { const LAS bf16* vp = T + (n * 16 + fr) * LDX + kk * 32 + 4 * fq;
            const u32x2 lo = *(const LAS u32x2*)vp, hi = *(const LAS u32x2*)(vp + 16); u32x4 w; w.x = lo.x; w.y = lo.y; w.z = hi.x; w.w = hi.y;
            o[n] = MFMA16(__builtin_bit_cast(bf16x8, w), pf[kk], o[n]); }
#pragma unroll
    for (int n = 0; n < 16; ++n) { const f32x4 v = o[n] * rinv; u32x2 w; w.x = pk2(v[0], v[1]); w.y = pk2(v[2], v[3]); *(u32x2*)(op + n * 16 + 4 * fq) = w; }
    __syncthreads();
}

#define XB_TMO      128
#define XB_XCNT(j)  (256  + 64 * (j))
#define XB_XSUB(j)  (1280 + 64 * (j))
#define XB_XGEN(j)  (2304 + 64 * (j))
#define XB_TOP      3328
#define XB_TOPGEN   3392
#define XCD_BAR_WORDS 3456
#define XB_SPIN_CAP (1u << 18)

__device__ __forceinline__ unsigned xb_ld(unsigned* p)              { return __hip_atomic_load(p, __ATOMIC_RELAXED, __HIP_MEMORY_SCOPE_AGENT); }
__device__ __forceinline__ unsigned xb_add(unsigned* p, unsigned v) { return __hip_atomic_fetch_add(p, v, __ATOMIC_RELAXED, __HIP_MEMORY_SCOPE_AGENT); }
__device__ __forceinline__ unsigned xb_xcc_id() { return (unsigned)__builtin_amdgcn_s_getreg((3 << 11) | 20) & 0xFu; }
#define XB_SPIN(cond, bar) do { unsigned _sp = 0; while (cond) { __builtin_amdgcn_s_sleep(1); \
    if ((++_sp & 255u) == 0u) { if (xb_ld(&(bar)[XB_TMO])) break; if (_sp > XB_SPIN_CAP) { atomicAdd(&(bar)[XB_TMO], 1u); break; } } } } while (0)

struct XcdBarrier {
    unsigned* bar; unsigned x;
    volatile LAS unsigned* st;
};

__device__ __forceinline__ XcdBarrier xcd_barrier_post(unsigned* bar, volatile LAS unsigned* st) {
    XcdBarrier b; b.bar = bar; b.x = xb_xcc_id(); b.st = st;
    if (threadIdx.x == 0) (void)xb_add(&bar[XB_XCNT(b.x)], 1u);
    return b;
}
__device__ __forceinline__ void xcd_barrier_complete(unsigned* bar, unsigned x, unsigned& nloc, unsigned& nx) {
    const unsigned G = gridDim.x * gridDim.y * gridDim.z;
    unsigned sum, cnt, mine, sp = 0u;
    for (;;) {
        sum = 0u; cnt = 0u; mine = 0u;
#pragma unroll
        for (unsigned j = 0; j < 16; ++j) { const unsigned c = xb_ld(&bar[XB_XCNT(j)]); sum += c; cnt += (c > 0u) ? 1u : 0u; mine = (j == x) ? c : mine; }
        if (sum == G) break;
        __builtin_amdgcn_s_sleep(1);
        if ((++sp & 255u) == 0u) { if (xb_ld(&bar[XB_TMO])) break; if (sp > XB_SPIN_CAP) { atomicAdd(&bar[XB_TMO], 1u); break; } }
    }
    nloc = mine > 0u ? mine : 1u; nx = cnt > 0u ? cnt : 1u;
}

__device__ __forceinline__ void xcd_barrier(const XcdBarrier& b) {
    asm volatile("s_waitcnt vmcnt(0)" ::: "memory");
    __syncthreads();
    if (threadIdx.x == 0) {
        unsigned* bar = b.bar;
        __builtin_amdgcn_s_waitcnt(0);
        unsigned nloc = b.st[0], nx = b.st[1];
        if (nloc == 0u) { xcd_barrier_complete(bar, b.x, nloc, nx); b.st[0] = nloc; b.st[1] = nx; }
        const unsigned old = xb_add(&bar[XB_XSUB(b.x)], 1u);
        const unsigned gen = old / nloc;
        if (old + 1u == (gen + 1u) * nloc) {
            __builtin_amdgcn_fence(__ATOMIC_RELEASE, "agent");
            asm volatile("s_waitcnt vmcnt(0)" ::: "memory");
            const unsigned og = xb_add(&bar[XB_TOP], 1u);
            const unsigned tg = og / nx;
            if (og + 1u == (tg + 1u) * nx) xb_add(&bar[XB_TOPGEN], 1u);
            else XB_SPIN(xb_ld(&bar[XB_TOPGEN]) == tg, bar);
            __builtin_amdgcn_fence(__ATOMIC_ACQUIRE, "agent");
            xb_add(&bar[XB_XGEN(b.x)], 1u);
            asm volatile("s_waitcnt vmcnt(0)" ::: "memory");
        } else {
            XB_SPIN(xb_ld(&bar[XB_XGEN(b.x)]) == gen, bar);
            __builtin_amdgcn_fence(__ATOMIC_ACQUIRE, "agent");
            asm volatile("s_waitcnt vmcnt(0)" ::: "memory");
        }
    }
    __syncthreads();
}


__device__ __forceinline__ void kvproj_coop(LAS unsigned char* lds, int t, const bf16* MEMN, const bf16* WXKV, bf16* Kx, bf16* VTx, int tid) {
    const int lane = tid & 63, wave = tid >> 6, fr = lane & 15, fq = lane >> 4;
    const int mt = (t >> 5) * 64, nt = (t & 31) * 64, mrow = (wave & 3) * 16, ncol = (wave >> 2) * 32;
    LAS bf16* As = (LAS bf16*)lds; LAS bf16* Bs = (LAS bf16*)(lds + 64 * 520 * 2);
    f32x4 c0 = (f32x4){0.f, 0.f, 0.f, 0.f}, c1 = c0;
    for (int kc = 0; kc < 2; ++kc) {
        u32x4 ra[8], rb[8];
#pragma unroll
        for (int i = 0; i < 8; ++i) { const int id = tid + 512 * i, r = id >> 6, ch = id & 63;
            ra[i] = *(const u32x4*)(MEMN + (size_t)(mt + r) * D + kc * 512 + ch * 8); rb[i] = *(const u32x4*)(WXKV + (size_t)(nt + r) * D + kc * 512 + ch * 8); }
        if (kc) __syncthreads();
#pragma unroll
        for (int i = 0; i < 8; ++i) { const int id = tid + 512 * i, r = id >> 6, ch = id & 63; *(LAS u32x4*)(As + r * 520 + ch * 8) = ra[i]; *(LAS u32x4*)(Bs + r * 520 + ch * 8) = rb[i]; }
        __syncthreads();
#pragma unroll
        for (int kk = 0; kk < 16; ++kk) { const bf16x8 av = *(const LAS bf16x8*)(As + (mrow + fr) * 520 + kk * 32 + fq * 8);
            const bf16x8 b0 = *(const LAS bf16x8*)(Bs + (ncol + fr) * 520 + kk * 32 + fq * 8), b1 = *(const LAS bf16x8*)(Bs + (ncol + 16 + fr) * 520 + kk * 32 + fq * 8);
            c0 = MFMA16(b0, av, c0); c1 = MFMA16(b1, av, c1); }
    }
    __syncthreads();
    const int row = mt + mrow + fr, b = row >> 8, key = row & 255;
#pragma unroll
    for (int j = 0; j < 2; ++j) { const f32x4 v = j ? c1 : c0; const int n = nt + ncol + 16 * j + 4 * fq; const bool isv = n >= 1024; const int nn = isv ? n - 1024 : n, h = nn >> 8, d = nn & 255;
        const unsigned w0 = pk2(v[0], v[1]), w1 = pk2(v[2], v[3]);
        if (!isv) { u32x2 w; w.x = w0; w.y = w1; *(u32x2*)(Kx + (size_t)(b * 4 + h) * 65536 + key * 256 + d) = w; }
        else { bf16* base = VTx + (size_t)(b * 4 + h) * 65536 + key;
            base[(d + 0) * 256] = (bf16)(w0 & 0xffffu); base[(d + 1) * 256] = (bf16)(w0 >> 16); base[(d + 2) * 256] = (bf16)(w1 & 0xffffu); base[(d + 3) * 256] = (bf16)(w1 >> 16); } }
}

__device__ __forceinline__ void xattn_softmax(f32x4 (&s)[16], bf16x8 (&pf)[8], float& rinv) {
    float mx = -3.0e38f;
#pragma unroll
    for (int n = 0; n < 16; ++n) mx = fmaxf(mx, fmaxf(fmaxf(s[n][0], s[n][1]), fmaxf(s[n][2], s[n][3])));
    mx = fmaxf(mx, __shfl_xor(mx, 16)); mx = fmaxf(mx, __shfl_xor(mx, 32));
    const float sc = 0.0625f * LOG2E; float sum = 0.f;
#pragma unroll
    for (int n = 0; n < 16; ++n)
#pragma unroll
        for (int r = 0; r < 4; ++r) { const float p = fexp2((s[n][r] - mx) * sc); s[n][r] = p; sum += p; }
    sum += __shfl_xor(sum, 16); sum += __shfl_xor(sum, 32);
    rinv = 1.f / sum;
#pragma unroll
    for (int kk = 0; kk < 8; ++kk) { u32x4 w; w.x = pk2(s[2 * kk][0], s[2 * kk][1]); w.y = pk2(s[2 * kk][2], s[2 * kk][3]); w.z = pk2(s[2 * kk + 1][0], s[2 * kk + 1][1]); w.w = pk2(s[2 * kk + 1][2], s[2 * kk + 1][3]);
        pf[kk] = __builtin_bit_cast(bf16x8, w); }
}
__device__ __forceinline__ void xattn_pair(LAS unsigned char* lds, int bh, size_t row_base, bf16* QO, const bf16* Kx, const bf16* VTx, int tid, const WsRef& wsr) {
    const int lane = tid & 63, wave = tid >> 6, fr = lane & 15, fq = lane >> 4, h = bh & 3;
    LAS bf16* T = (LAS bf16*)lds;
    bf16* qp0 = QO + (row_base + wave * 16 + fr) * D + h * 256; bf16* qp1 = qp0 + (size_t)128 * D;
    const u32x4* kg = (const u32x4*)(Kx + (size_t)bh * 65536);
#pragma unroll 4
    for (int i = 0; i < 16; ++i) { const int id = tid + 512 * i, r = id >> 5, ch = id & 31; *(LAS u32x4*)(T + r * LDX + ch * 8) = kg[id]; }
    __syncthreads();
    bf16x8 pf0[8], pf1[8]; float rinv0, rinv1;
#pragma unroll
    for (int half = 0; half < 2; ++half) {
        const bf16* qp = half ? qp1 : qp0;
        bf16x8 qf[8];
#pragma unroll
        for (int kk = 0; kk < 8; ++kk) qf[kk] = *(const bf16x8*)(qp + kk * 32 + fq * 8);
        f32x4 sx[16];
#pragma unroll
        for (int n = 0; n < 16; ++n) sx[n] = (f32x4){0.f, 0.f, 0.f, 0.f};
#pragma unroll
        for (int kk = 0; kk < 8; ++kk)
#pragma unroll
            for (int n = 0; n < 16; ++n) { const bf16x8 kf = *(const LAS bf16x8*)(T + (n * 16 + fr) * LDX + kk * 32 + fq * 8); sx[n] = MFMA16(kf, qf[kk], sx[n]); }
        if (half == 0) xattn_softmax(sx, pf0, rinv0); else xattn_softmax(sx, pf1, rinv1);
        __builtin_amdgcn_sched_barrier(0);
    }
    __syncthreads();
    const u32x4* vg = (const u32x4*)(VTx + (size_t)bh * 65536);
#pragma unroll 4
    for (int i = 0; i < 16; ++i) { const int id = tid + 512 * i, r = id >> 5, ch = id & 31; *(LAS u32x4*)(T + r * LDX + ch * 8) = vg[id]; }
    __syncthreads();
#pragma unroll
    for (int nh = 0; nh < 2; ++nh) {
        f32x4 o0[8], o1[8];
#pragma unroll
        for (int n = 0; n < 8; ++n) { o0[n] = (f32x4){0.f, 0.f, 0.f, 0.f}; o1[n] = (f32x4){0.f, 0.f, 0.f, 0.f}; }
#pragma unroll
        for (int kk = 0; kk < 8; ++kk)
#pragma unroll
            for (int n = 0; n < 8; ++n) { const LAS bf16* vp = T + ((nh * 8 + n) * 16 + fr) * LDX + kk * 32 + 4 * fq;
                const u32x2 lo = *(const LAS u32x2*)vp, hi = *(const LAS u32x2*)(vp + 16); u32x4 w; w.x = lo.x; w.y = lo.y; w.z = hi.x; w.w = hi.y; const bf16x8 vf = __builtin_bit_cast(bf16x8, w);
                o0[n] = MFMA16(vf, pf0[kk], o0[n]); o1[n] = MFMA16(vf, pf1[kk], o1[n]); }
#pragma unroll
        for (int n = 0; n < 8; ++n) { const f32x4 v0 = o0[n] * rinv0, v1 = o1[n] * rinv1; u32x2 w0, w1; w0.x = pk2(v0[0], v0[1]); w0.y = pk2(v0[2], v0[3]); w1.x = pk2(v1[0], v1[1]); w1.y = pk2(v1[2], v1[3]);
            wt_store8(wsr, qp0 + (nh * 8 + n) * 16 + 4 * fq, w0); wt_store8(wsr, qp1 + (nh * 8 + n) * 16 + 4 * fq, w1); }
        __builtin_amdgcn_sched_barrier(0);
    }
    __syncthreads();
}

__device__ __forceinline__ void panel_barrier(unsigned* cnt, bool release) {
    asm volatile("s_waitcnt vmcnt(0)" ::: "memory");
    __syncthreads();
    if (threadIdx.x == 0) {
        if (release) { __builtin_amdgcn_fence(__ATOMIC_RELEASE, "agent"); asm volatile("s_waitcnt vmcnt(0)" ::: "memory"); }
        __hip_atomic_fetch_add(cnt, 1u, __ATOMIC_RELAXED, __HIP_MEMORY_SCOPE_AGENT);
        unsigned spins = 0;
        while (__hip_atomic_load(cnt, __ATOMIC_RELAXED, __HIP_MEMORY_SCOPE_AGENT) < 4u) { __builtin_amdgcn_s_sleep(1); if (++spins > (1u << 22)) break; }
        __builtin_amdgcn_fence(__ATOMIC_ACQUIRE, "agent");
        asm volatile("s_waitcnt vmcnt(0)" ::: "memory");
    }
    __syncthreads();
}
__device__ __forceinline__ void local_rw_sync() {
    asm volatile("s_waitcnt vmcnt(0)" ::: "memory");
    __syncthreads();
    if (threadIdx.x == 0) { __builtin_amdgcn_fence(__ATOMIC_ACQUIRE, "agent"); asm volatile("s_waitcnt vmcnt(0)" ::: "memory"); }
    __syncthreads();
}
struct Args { const float* in[23]; float* out; unsigned char* ws; int ph_lo, ph_hi; };
__global__ void __launch_bounds__(512, 2) fwd_mega(Args a) {
    extern __shared__ __attribute__((aligned(16))) unsigned char lds_raw[];
    LAS unsigned char* lds = (LAS unsigned char*)lds_raw;
    cg::grid_group grid = cg::this_grid();
    const int tid = threadIdx.x, lane = tid & 63, wave = __builtin_amdgcn_readfirstlane(tid >> 6);
    const int G = gridDim.x, bid = blockIdx.x;
    const int lo = a.ph_lo, hi = a.ph_hi;
#define IN(k) (lo <= (k) && (k) < hi)
#ifndef DUP_MASK
#define DUP_MASK 0
#endif
#define REP(k) for (int rep_ = 0; rep_ < 1 + ((DUP_MASK >> (k)) & 1); ++rep_)
#define SEAM(k) do { if (IN(k) && IN((k) + 1)) xcd_barrier(bar); } while (0)
    volatile LAS unsigned* MISC = (volatile LAS unsigned*)(lds + MISC_OFF);
    if (tid < 16) MISC[tid] = 0u;
    __syncthreads();
    if (lo < 0) grid.sync();
    XcdBarrier bar = xcd_barrier_post((unsigned*)(a.ws + WS_CTL) + 1024, MISC + 8);
    unsigned char* ws = a.ws;
    WsRef wsr; wsr.r = __builtin_amdgcn_make_buffer_rsrc((void*)a.ws, (short)0, 0x10000000, 0x00020000); wsr.base = a.ws;
    const float* x = a.in[0]; const float* mem = a.in[1]; const int* pos = (const int*)a.in[2];
    bf16* WIN = (bf16*)(ws + WS_WIN); bf16* WOUT = (bf16*)(ws + WS_WOUT); bf16* WXQ = (bf16*)(ws + WS_WXQ); bf16* WXKV = (bf16*)(ws + WS_WXKV);
    bf16* WXO = (bf16*)(ws + WS_WXO); bf16* WFF1 = (bf16*)(ws + WS_WFF1); bf16* WFF2 = (bf16*)(ws + WS_WFF2);
    bf16* MEMN = (bf16*)(ws + WS_MEMN); bf16* KX = (bf16*)(ws + WS_KX); bf16* VTX = (bf16*)(ws + WS_VTX);
    bf16* H = (bf16*)(ws + WS_H); bf16* ST = (bf16*)a.out;     bf16* MIX = (bf16*)(ws + WS_MIX); bf16* QO = (bf16*)(ws + WS_QO); bf16* KVC = (bf16*)(ws + WS_QO);
    bf16* PROJ = (bf16*)(ws + WS_PROJ); bf16* F = (bf16*)(ws + WS_F);
    float* out = a.out; float* RSQ0 = (float*)(ws + WS_CTL + 65536); float* RSQ1 = (float*)(ws + WS_CTL + 131072); float* RSQ2 = (float*)(ws + WS_CTL + 196608); float* RSQX = (float*)(ws + WS_CTL + 524288);
    const int gw = bid * 8 + wave, NGW = G * 8;

    if (IN(0)) REP(0) {
        LAS float* scr = (LAS float*)(lds + wave * 16896);
        constexpr int I_IN = 16 * 48, I_KV = 16 * 32;
        constexpr int NIT = I_IN + I_KV;
        for (int it = gw; it < NIT; it += NGW) { int r = it;
            if (r < I_IN) { p0_transpose_item64(wsr, a.in[4], D, INC, WIN, scr, r, lane, a.in[3]); continue; } r -= I_IN;
            p0_transpose_item64(wsr, a.in[17], D, 2 * D, WXKV, scr, r, lane); }
        for (int m = gw; m < M; m += 2 * NGW) {
            const int m2 = (m + NGW < M) ? m + NGW : m;
            const f32x4* xr0 = (const f32x4*)(x + (size_t)m * D) + 2 * lane; const f32x4* xr1 = (const f32x4*)(x + (size_t)m2 * D) + 2 * lane;
            f32x4 v0[4], v1[4]; float s0 = 0.f, s1 = 0.f;
#pragma unroll
            for (int j = 0; j < 2; ++j) { v0[2 * j] = xr0[128 * j]; v0[2 * j + 1] = xr0[128 * j + 1]; v1[2 * j] = xr1[128 * j]; v1[2 * j + 1] = xr1[128 * j + 1]; }
#pragma unroll
            for (int j = 0; j < 4; ++j) { s0 += (v0[j].x * v0[j].x + v0[j].y * v0[j].y) + (v0[j].z * v0[j].z + v0[j].w * v0[j].w); s1 += (v1[j].x * v1[j].x + v1[j].y * v1[j].y) + (v1[j].z * v1[j].z + v1[j].w * v1[j].w); }
#pragma unroll
            for (int o = 1; o < 64; o <<= 1) { s0 += __shfl_xor(s0, o); s1 += __shfl_xor(s1, o); }
            if (lane == 0) { RSQX[m] = s0; RSQX[m2] = s1; }
            bf16* o0 = H + (size_t)m * D + 8 * lane; bf16* o1 = H + (size_t)m2 * D + 8 * lane;
#pragma unroll
            for (int j = 0; j < 2; ++j) { const f32x4 a0 = v0[2 * j], b0 = v0[2 * j + 1], a1 = v1[2 * j], b1 = v1[2 * j + 1];
                u32x4 p0, p1; p0.x = pk2(a0.x, a0.y); p0.y = pk2(a0.z, a0.w); p0.z = pk2(b0.x, b0.y); p0.w = pk2(b0.z, b0.w); p1.x = pk2(a1.x, a1.y); p1.y = pk2(a1.z, a1.w); p1.z = pk2(b1.x, b1.y); p1.w = pk2(b1.z, b1.w);
                wt_store16(wsr, o0 + 512 * j, p0); if (m2 != m) wt_store16(wsr, o1 + 512 * j, p1); }
        }
        for (int m = gw; m < BATCH * 256; m += NGW) rms_row_to_bf16(mem + (size_t)m * D, a.in[15], MEMN + (size_t)m * D, lane);
        __syncthreads();
    }
    SEAM(0);
    if (IN(1)) REP(1) {
        { pg8::Gemm g{H, WIN, M, INC, D}; pg8::StaticOrder S; S.init(M, INC, G, bid); pg8::EpiBf16<0> E{PROJ, INC, RSQX};
          pg8::gemm_phase<pg8::EpiBf16<0>, pg8::StaticOrder, true, true>(lds, g, S, E); }
    }
    SEAM(1);
    if (IN(2)) REP(2) {
        { UnitRaw raw; int u = bid; if (u < 512) raw_load<false>(raw, u, PROJ, pos, tid);
          for (; u < 512; u += G) kv_unit(lds, u, PROJ, pos, a.in[5], a.in[6], KVC, tid, raw, (u + G < 512) ? u + G : -1); }
        for (int u = bid; u < 512; u += G) conv_unit(lds, u, PROJ, a.in[9], a.in[10], a.in[11], a.in[12], MIX, tid, wsr);
    }
    SEAM(2);
    if (IN(3)) REP(3) {
        for (int t = bid; t < 256; t += G) kvproj_coop(lds, t, MEMN, WXKV, KX, VTX, tid);
        const int sb = bid, sG = G;
        if (sb >= 0) {
            LAS float* scr = (LAS float*)(lds + wave * 16896);
            constexpr int I_SQ = 16 * 16, I_F1 = 16 * 64, I_F2 = 64 * 16, NIT3 = 3 * I_SQ + I_F1 + I_F2;
            for (int it = sb * 8 + wave; it < NIT3; it += sG * 8) { int r = it;
                if (r < I_SQ) { p0_transpose_item64(wsr, a.in[13], D, D, WOUT, scr, r, lane); continue; } r -= I_SQ;
                if (r < I_SQ) { p0_transpose_item64(wsr, a.in[16], D, D, WXQ, scr, r, lane, a.in[14]); continue; } r -= I_SQ;
                if (r < I_SQ) { p0_transpose_item64(wsr, a.in[18], D, D, WXO, scr, r, lane); continue; } r -= I_SQ;
                if (r < I_F1) { p0_transpose_item64(wsr, a.in[20], D, FF, WFF1, scr, r, lane, a.in[19]); continue; } r -= I_F1;
                p0_transpose_item64(wsr, a.in[21], FF, D, WFF2, scr, r, lane); }
        }
        if (sb >= 0)
        for (int idx = sb * 512 + tid; idx < 131072; idx += sG * 512) {
            const int p = idx & 8191, bh = (idx >> 13) & 7, dir = idx >> 16, h = bh & 3;
            const float lg = log_sigmoid(dir ? a.in[6][h] : a.in[5][h]); const float dec = expf(lg * 128.f);
            const size_t base = (size_t)(dir * 8 + bh) * 64 * 16384 + (size_t)p * 2;
            const bf16* kv = KVC + base; bf16* st = ST + base;
            float s0 = 0.f, s1 = 0.f;
            const unsigned* kvw = (const unsigned*)kv; unsigned* stw = (unsigned*)st;
            for (int c0 = 0; c0 < 64; c0 += 16) {
                unsigned w[16];
#pragma unroll
                for (int i = 0; i < 16; ++i) { const int cc = dir ? 63 - (c0 + i) : c0 + i; w[i] = kvw[(size_t)cc * 8192]; }
#pragma unroll
                for (int i = 0; i < 16; ++i) { const int cc = dir ? 63 - (c0 + i) : c0 + i; stw[(size_t)cc * 8192] = pk2(s0, s1); s0 = fmaf(dec, s0, bflo(w[i])); s1 = fmaf(dec, s1, bfhi(w[i])); }
            }
        }
    }
    SEAM(3);
    if (IN(4)) REP(4) {
        for (int u = bid; u < 512; u += G) ret_unit(lds, u, PROJ, pos, a.in[5], a.in[6], ST, a.in[7], a.in[8], MIX, tid, wsr);
    }
    SEAM(4);
    const bool panel_mode = (G == 256);
    pg8::Unit myu; { pg8::StaticOrder S; S.init(M, D, G, bid); if (!S.next(0, myu)) { myu.pm = 0; myu.pn = 0; } }
    unsigned* pbar = (unsigned*)(ws + WS_CTL + 327680) + 64 * myu.pm;
#define PSEAM(k, idx, rel) do { if (IN(k) && IN((k) + 1)) { if (panel_mode) panel_barrier(pbar + (idx) * 4096, rel); else xcd_barrier(bar); } } while (0)
    if (IN(5)) {
        pg8::Gemm g{MIX, WOUT, M, D, D}; pg8::StaticOrder S; S.init(M, D, G, bid); pg8::EpiResidual<1> E{nullptr, H, nullptr, D, RSQ0};
        pg8::gemm_phase<pg8::EpiResidual<1>, pg8::StaticOrder, true, true>(lds, g, S, E);
    }
    PSEAM(5, 0, false);
    if (IN(7)) REP(7) {
        pg8::Gemm g{H, WXQ, M, D, D}; pg8::StaticOrder S; S.init(M, D, G, bid); pg8::EpiBf16<0> E{MIX, D, RSQ0};
        pg8::gemm_phase<pg8::EpiBf16<0>, pg8::StaticOrder, true, true>(lds, g, S, E);
    }
    if (IN(7) && IN(8)) { if (panel_mode) local_rw_sync(); else xcd_barrier(bar); }
    if (IN(8)) {
        if (panel_mode) { const int bh = (myu.pm >> 5) * 4 + myu.pn;
            xattn_pair(lds, bh, (size_t)myu.pm * 256, MIX, KX, VTX, tid, wsr); }
        else { for (int u = bid; u < 512; u += G) xattn_unit(lds, u, MIX, MIX, KX, VTX, tid); }
    }
    PSEAM(8, 1, !panel_mode);
    if (IN(9)) {
        pg8::Gemm g{MIX, WXO, M, D, D}; pg8::StaticOrder S; S.init(M, D, G, bid); pg8::EpiResidual<1> E{nullptr, H, nullptr, D, RSQ1};
        pg8::gemm_phase<pg8::EpiResidual<1>, pg8::StaticOrder, true, true>(lds, g, S, E);
    }
    PSEAM(9, 2, false);
    if (IN(11)) REP(11) {
        pg8::Gemm g{H, WFF1, M, FF, D}; pg8::StaticOrder S; S.init(M, FF, G, bid); pg8::EpiBf16<1> E{F, FF, RSQ1};
        pg8::gemm_phase<pg8::EpiBf16<1>, pg8::StaticOrder, true, true>(lds, g, S, E);
    }
    PSEAM(11, 3, false);
    const bool fuse_final = (G == 256);
    if (IN(12)) {
        pg8::Gemm g{F, WFF2, M, D, FF}; pg8::StaticOrder S; S.init(M, D, G, bid);
        if (fuse_final) { pg8::EpiFinalNorm E{H, out, D, a.in[22], RSQ2, (unsigned*)(ws + WS_CTL + 262144)};
            pg8::gemm_phase<pg8::EpiFinalNorm, pg8::StaticOrder, false, true>(lds, g, S, E); }
        else { pg8::EpiResidual<2> E{nullptr, H, out, D, nullptr};
            pg8::gemm_phase<pg8::EpiResidual<2>, pg8::StaticOrder, true, true>(lds, g, S, E); }
    }
    if (!fuse_final) {
        SEAM(12);
        if (IN(13)) { for (int m = gw; m < M; m += NGW) rms_row_to_f32(out + (size_t)m * D, a.in[22], out + (size_t)m * D, lane); }
    }
#undef IN
#undef SEAM
}

extern "C" void kernel_launch(void* const* d_in, const int* in_sizes, int n_in, void* d_out, int out_size, void* d_ws, size_t ws_size, hipStream_t stream) {
    static int grid = 0;
    if (grid == 0) {
        if (n_in != 23 || out_size != M * D || ws_size < WS_END) { fprintf(stderr, "kernel_launch: unexpected problem (n_in %d out %d ws %zu)\n", n_in, out_size, ws_size); grid = -1; return; }
        int dev = 0, cus = 0, per_cu = 0;
        (void)hipGetDevice(&dev); (void)hipDeviceGetAttribute(&cus, hipDeviceAttributeMultiprocessorCount, dev);
        if (hipFuncSetAttribute((const void*)fwd_mega, hipFuncAttributeMaxDynamicSharedMemorySize, LDS_BYTES) != hipSuccess) { fprintf(stderr, "kernel_launch: hipFuncSetAttribute failed\n"); grid = -1; return; }
        if (hipOccupancyMaxActiveBlocksPerMultiprocessor(&per_cu, (const void*)fwd_mega, 512, LDS_BYTES) != hipSuccess || per_cu < 1) { fprintf(stderr, "kernel_launch: occupancy query says %d\n", per_cu); per_cu = 1; }
        (void)hipGetLastError();
        grid = cus * per_cu;
        if (grid <= 0) grid = 256;
    }
    if (grid < 0) return;
    if (hipMemsetAsync((char*)d_ws + WS_CTL, 0, CTL_ZERO_BYTES, stream) != hipSuccess) { fprintf(stderr, "kernel_launch: memset failed\n"); return; }
    Args a{};
    for (int i = 0; i < 23; ++i) a.in[i] = (const float*)d_in[i];
    a.out = (float*)d_out; a.ws = (unsigned char*)d_ws;
#if MK_N_LAUNCHES == 1
    a.ph_lo = 0; a.ph_hi = NPH;
    void* args[] = {&a};
    hipError_t e = hipLaunchCooperativeKernel((const void*)fwd_mega, dim3(grid), dim3(512), args, LDS_BYTES, stream);
    if (e != hipSuccess) fprintf(stderr, "cooperative launch failed: %s (grid %d)\n", hipGetErrorString(e), grid);
#else
    for (int p = 0; p < NPH; ++p) { a.ph_lo = p; a.ph_hi = p + 1; hipLaunchKernelGGL(fwd_mega, dim3(grid), dim3(512), LDS_BYTES, stream, a); }
#endif
}
```
